# Optimizing an MI355X kernel written in HIP

```python
import math
import jax, jax.numpy as jnp
from jax import lax
import numpy as np

D_MODEL = 1024
BATCH = 16
SEQ = 2048
DEPTH = 2

CTX_LEN = 256
GRID_W = 64
HEAD_DIM = 64
ROPE_THETA = 10000.0
NORM_EPS = 1e-6
Q_BLOCK = 128

DA_HEADS = 4
DA_QK = DA_HEADS * 2 * HEAD_DIM
DA_V = DA_HEADS * 2 * HEAD_DIM
DA_SCALE = HEAD_DIM ** -0.5
GQA_Q_HEADS = 8
GQA_KV_HEADS = 2
GQA_GROUP = GQA_Q_HEADS // GQA_KV_HEADS
GQA_Q = GQA_Q_HEADS * HEAD_DIM
GQA_KV = GQA_KV_HEADS * HEAD_DIM
GQA_SCALE = HEAD_DIM ** -0.5
CONV_DIM = 512
CONV_WIDTH = 3
N_BRANCH = 3
N_MOD = 6
D_FF = -(-(8 * D_MODEL) // (3 * 256)) * 256
IN_SIZES = (DA_QK, DA_QK, DA_V, GQA_Q, GQA_KV, GQA_KV, CONV_DIM, CONV_DIM, CONV_DIM, N_BRANCH * D_MODEL)
D_IN = sum(IN_SIZES)

kernel_name = "hybrid_diffattn_gqa_shortconv_adaln_prefix_block"


def rmsnorm(x, g):
    xf = x.astype(jnp.float32)
    y = xf * lax.rsqrt(jnp.mean(xf * xf, axis=-1, keepdims=True) + NORM_EPS)
    return (y * g.astype(jnp.float32)).astype(x.dtype)


def modulate(h, shift, scale):
    return h * (1.0 + scale) + shift


def split_cols(z, sizes):
    out = []
    start = 0
    for n in sizes:
        out.append(z[..., start:start + n])
        start += n
    return out


def axial_rope_tables(seq, dtype):
    rows = seq // GRID_W
    row = jnp.repeat(jnp.arange(rows, dtype=jnp.float32), GRID_W)
    col = jnp.tile(jnp.arange(GRID_W, dtype=jnp.float32), rows)
    n_freq = HEAD_DIM // 4
    inv_freq = ROPE_THETA ** (-jnp.arange(n_freq, dtype=jnp.float32) / n_freq)
    ang = jnp.stack([row[:, None] * inv_freq, col[:, None] * inv_freq], axis=1)
    return jnp.cos(ang).astype(dtype), jnp.sin(ang).astype(dtype)


def apply_axial_rope(x, rope):
    cos, sin = rope
    b, s, h, d = x.shape
    xa = x.reshape(b, s, h, 2, 2, d // 4)
    x1, x2 = xa[:, :, :, :, 0], xa[:, :, :, :, 1]
    cs, sn = cos[None, :, None], sin[None, :, None]
    out = jnp.stack([x1 * cs - x2 * sn, x2 * cs + x1 * sn], axis=4)
    return out.reshape(b, s, h, d)


def block_attention(q, k, v, scale):
    b, s, hk, g, d = q.shape
    nb = s // Q_BLOCK
    qb = jnp.moveaxis(q.reshape(b, nb, Q_BLOCK, hk, g, d), 1, 0)

    def one_block(qi):
        sc = jnp.einsum('bqhgd,bkhd->bhgqk', qi, k, preferred_element_type=jnp.float32) * scale
        p = jax.nn.softmax(sc, axis=-1)
        return jnp.einsum('bhgqk,bkhe->bqhge', p.astype(v.dtype), v)

    ob = lax.map(one_block, qb)
    return jnp.moveaxis(ob, 0, 1).reshape(b, s, hk, g, v.shape[-1])


def short_conv(u, w):
    n = u.shape[1]
    up = jnp.pad(u, ((0, 0), (1, 1), (0, 0)))
    return up[:, :n] * w[0] + up[:, 1:n + 1] * w[1] + up[:, 2:] * w[2]


def mixer_inputs(h, w_in, q_norm_g, k_norm_g, rope):
    b, s, _ = h.shape
    a_q, a_k, a_v, b_q, b_k, b_v, c_b, c_c, c_u, gates = split_cols(h @ w_in, IN_SIZES)
    a_q1, a_q2 = jnp.split(a_q.reshape(b, s, DA_HEADS, 2 * HEAD_DIM), 2, axis=-1)
    a_k1, a_k2 = jnp.split(a_k.reshape(b, s, DA_HEADS, 2 * HEAD_DIM), 2, axis=-1)
    a_v = a_v.reshape(b, s, DA_HEADS, 2 * HEAD_DIM)
    b_q = rmsnorm(b_q.reshape(b, s, GQA_Q_HEADS, HEAD_DIM), q_norm_g)
    b_k = rmsnorm(b_k.reshape(b, s, GQA_KV_HEADS, HEAD_DIM), k_norm_g)
    b_v = b_v.reshape(b, s, GQA_KV_HEADS, HEAD_DIM)
    if rope is not None:
        a_q1, a_q2, a_k1, a_k2 = (apply_axial_rope(t, rope) for t in (a_q1, a_q2, a_k1, a_k2))
        b_q, b_k = apply_axial_rope(b_q, rope), apply_axial_rope(b_k, rope)
    return (a_q1, a_q2, b_q), (a_k1, a_k2, a_v, b_k, b_v), (c_b, c_c, c_u, gates)


def mixer_outputs(queries, kv, local, conv_w, lam, lam_init, subln_g, w_a, w_b, w_c, w_out):
    a_q1, a_q2, b_q = queries
    a_k1, a_k2, a_v, b_k, b_v = kv
    c_b, c_c, c_u, gates = local
    b, s = b_q.shape[:2]
    o1 = block_attention(a_q1[:, :, :, None], a_k1, a_v, DA_SCALE)[:, :, :, 0]
    o2 = block_attention(a_q2[:, :, :, None], a_k2, a_v, DA_SCALE)[:, :, :, 0]
    y_a = (rmsnorm(o1 - lam.astype(o1.dtype) * o2, subln_g) * (1.0 - lam_init)).reshape(b, s, DA_V)
    y_b = block_attention(b_q.reshape(b, s, GQA_KV_HEADS, GQA_GROUP, HEAD_DIM), b_k, b_v, GQA_SCALE)
    y_b = y_b.reshape(b, s, GQA_Q)
    y_c = c_b * short_conv(c_c * c_u, conv_w)
    g = jax.nn.sigmoid(gates.astype(jnp.float32)).astype(gates.dtype)
    g_a, g_b, g_c = jnp.split(g, N_BRANCH, axis=-1)
    merged = g_a * (y_a @ w_a) + g_b * (y_b @ w_b) + g_c * (y_c @ w_c)
    return merged @ w_out


def swiglu(h, w_gu, w_down):
    gt, up = jnp.split(h @ w_gu, 2, axis=-1)
    return (jax.nn.silu(gt) * up) @ w_down


def setup_inputs(seed: int = 0) -> dict:
    key = jax.random.key(seed)
    ks = jax.random.split(key, 32)
    nrm = lambda k, shape, s: jax.random.normal(k, shape, jnp.float32) * s
    gain = lambda k, shape: 1.0 + 0.02 * jax.random.normal(k, shape, jnp.float32)
    L, D = DEPTH, D_MODEL
    return {
        "x": nrm(ks[0], (BATCH, SEQ, D), 1.0),
        "c": nrm(ks[1], (BATCH, D), 1.0),
        "ctx": nrm(ks[2], (BATCH, CTX_LEN, D), 1.0),
        "c_ctx": nrm(ks[3], (D,), 1.0),
        "w_mod": nrm(ks[4], (L, D, N_MOD * D), 0.3 * D ** -0.5),
        "b_mod": nrm(ks[5], (L, N_MOD * D), 0.02),
        "norm1_g": gain(ks[6], (L, D)),
        "norm2_g": gain(ks[7], (L, D)),
        "w_in": nrm(ks[8], (L, D, D_IN), D ** -0.5),
        "lam_q1": nrm(ks[9], (L, HEAD_DIM), 0.1),
        "lam_k1": nrm(ks[10], (L, HEAD_DIM), 0.1),
        "lam_q2": nrm(ks[11], (L, HEAD_DIM), 0.1),
        "lam_k2": nrm(ks[12], (L, HEAD_DIM), 0.1),
        "diff_subln_g": gain(ks[13], (L, 2 * HEAD_DIM)),
        "q_norm_g": gain(ks[14], (L, HEAD_DIM)),
        "k_norm_g": gain(ks[15], (L, HEAD_DIM)),
        "conv_w": nrm(ks[16], (L, CONV_WIDTH, CONV_DIM), CONV_WIDTH ** -0.5),
        "w_branch_a": nrm(ks[17], (L, DA_V, D), DA_V ** -0.5),
        "w_branch_b": nrm(ks[18], (L, GQA_Q, D), GQA_Q ** -0.5),
        "w_branch_c": nrm(ks[19], (L, CONV_DIM, D), CONV_DIM ** -0.5),
        "w_out": nrm(ks[20], (L, D, D), D ** -0.5),
        "w_ffn_gu": nrm(ks[21], (L, D, 2 * D_FF), D ** -0.5),
        "w_ffn_down": nrm(ks[22], (L, D_FF, D), D_FF ** -0.5),
        "final_g": gain(ks[23], (D,)),
    }


def reference(x, c, ctx, c_ctx, w_mod, b_mod, norm1_g, norm2_g, w_in, lam_q1, lam_k1, lam_q2, lam_k2,
              diff_subln_g, q_norm_g, k_norm_g, conv_w, w_branch_a, w_branch_b, w_branch_c, w_out,
              w_ffn_gu, w_ffn_down, final_g):
    seq = x.shape[1]
    rope = axial_rope_tables(seq, x.dtype)
    silu_c = jax.nn.silu(c)
    silu_cc = jax.nn.silu(c_ctx)
    for l in range(DEPTH):
        lam_init = 0.8 - 0.6 * math.exp(-0.3 * l)
        lam = (jnp.exp(jnp.sum(lam_q1[l].astype(jnp.float32) * lam_k1[l].astype(jnp.float32)))
               - jnp.exp(jnp.sum(lam_q2[l].astype(jnp.float32) * lam_k2[l].astype(jnp.float32)))
               + lam_init)
        mx = jnp.split(silu_c @ w_mod[l] + b_mod[l], N_MOD, axis=-1)
        mx = [m[:, None, :] for m in mx]
        mc = jnp.split(silu_cc @ w_mod[l] + b_mod[l], N_MOD, axis=-1)
        out_args = (conv_w[l], lam, lam_init, diff_subln_g[l], w_branch_a[l], w_branch_b[l],
                    w_branch_c[l], w_out[l])
        hc = modulate(rmsnorm(ctx, norm1_g[l]), mc[0], mc[1])
        qc, kvc, locc = mixer_inputs(hc, w_in[l], q_norm_g[l], k_norm_g[l], None)
        hx = modulate(rmsnorm(x, norm1_g[l]), mx[0], mx[1])
        qx, kvx, locx = mixer_inputs(hx, w_in[l], q_norm_g[l], k_norm_g[l], rope)
        kv_all = tuple(jnp.concatenate([kc_, kx_], axis=1) for kc_, kx_ in zip(kvc, kvx))
        x = x + mx[2] * mixer_outputs(qx, kv_all, locx, *out_args)
        x = x + mx[5] * swiglu(modulate(rmsnorm(x, norm2_g[l]), mx[3], mx[4]), w_ffn_gu[l], w_ffn_down[l])
        if l < DEPTH - 1:
            ctx = ctx + mc[2] * mixer_outputs(qc, kvc, locc, *out_args)
            ctx = ctx + mc[5] * swiglu(modulate(rmsnorm(ctx, norm2_g[l]), mc[3], mc[4]),
                                       w_ffn_gu[l], w_ffn_down[l])
    return rmsnorm(x, final_g)
```

```cpp
#include <hip/hip_runtime.h>
#include <hip/hip_cooperative_groups.h>
#include <cstdio>
#include <cstdint>
namespace cg = cooperative_groups;

#define LAS __attribute__((address_space(3)))
typedef unsigned short bf16_t;
typedef short bf16x8 __attribute__((ext_vector_type(8)));
typedef float f32x2 __attribute__((ext_vector_type(2)));
typedef float f32x4 __attribute__((ext_vector_type(4)));
typedef float f32x16 __attribute__((ext_vector_type(16)));
typedef unsigned u32x2 __attribute__((ext_vector_type(2)));
typedef unsigned u32x4 __attribute__((ext_vector_type(4)));
typedef __bf16 bf16x2_t __attribute__((ext_vector_type(2)));

__device__ __forceinline__ unsigned pk2(float lo, float hi) { f32x2 v = {lo, hi}; bf16x2_t b = __builtin_convertvector(v, bf16x2_t); return __builtin_bit_cast(unsigned, b); }
__device__ __forceinline__ float bflo(unsigned w) { return __uint_as_float(w << 16); }
__device__ __forceinline__ float bfhi(unsigned w) { return __uint_as_float(w & 0xffff0000u); }
__device__ __forceinline__ void st4(bf16_t* p, f32x4 v) { u32x2 w; w.x = pk2(v[0], v[1]); w.y = pk2(v[2], v[3]); *(u32x2*)p = w; }
__device__ __forceinline__ void st8(bf16_t* p, f32x4 a, f32x4 b) { u32x4 w; w.x = pk2(a[0], a[1]); w.y = pk2(a[2], a[3]); w.z = pk2(b[0], b[1]); w.w = pk2(b[2], b[3]); *(u32x4*)p = w; }
__host__ __device__ __forceinline__ int ip32(int x) { return 16 * ((x >> 2) & 1) + 4 * (x >> 3) + (x & 3); }
__device__ __forceinline__ f32x4 ld4(const bf16_t* p) { const u32x2 w = *(const u32x2*)p; return (f32x4){bflo(w.x), bfhi(w.x), bflo(w.y), bfhi(w.y)}; }
__device__ __forceinline__ bf16_t f2bf(float f) { return (bf16_t)(pk2(f, 0.f) & 0xffffu); }
__device__ __forceinline__ float sx(float v, int m, int lane) { return __int_as_float(__builtin_amdgcn_ds_bpermute((lane ^ m) << 2, __float_as_int(v))); }
__device__ __forceinline__ float sigmoidf_(float z) { return __builtin_amdgcn_rcpf(1.0f + __expf(-z)); }

constexpr int D = 1024, SEQ = 2048, CTXL = 256, LK = 2304, NT_LAT = 36, NT_CTX = 4;
constexpr int M_LAT = 32768, M_CTX = 4096, M_ALL = 36864;
constexpr int D_IN = 6912, D_FF = 2816, NMOD = 6144, HROWS = 18432;
constexpr float EPS = 1e-6f;
constexpr float QSCALE = 0.125f * 1.4426950408889634f;

constexpr size_t MiB = 1u << 20;
constexpr size_t WT_LAYER = 36700160;
constexpr size_t OFF_WIN = 0, OFF_WBR = 14155776, OFF_WOUT = 17301504, OFF_WGU = 19398656, OFF_WDN = 30932992;
constexpr size_t WS_MOD = 70 * MiB, WS_ROPE = 70 * MiB + 896 * 1024, WS_BAR = 70 * MiB + 960 * 1024;
constexpr size_t WS_CTXS = 71 * MiB, WS_XN = 87 * MiB, WS_BIG = 159 * MiB;
constexpr size_t B_AQ = WS_BIG, B_BQ = WS_BIG + 18 * MiB, B_AK = WS_BIG + 36 * MiB, B_AV = WS_BIG + 54 * MiB, B_BK = WS_BIG + 72 * MiB, B_BV = WS_BIG + 76 * MiB + 512 * 1024;
constexpr size_t B_CB = WS_BIG + 81 * MiB, B_PB = WS_BIG + 101 * MiB, B_G = WS_BIG + 121 * MiB, B_Y = WS_BIG + 241 * MiB, B_SCR = WS_BIG + 301 * MiB;
constexpr size_t B_XN2 = WS_BIG, B_H = WS_BIG + 72 * MiB;
constexpr size_t WS_SWGU = WS_BIG + 333 * MiB, WS_SWIN = WS_SWGU + 1 * MiB, WS_RSS = WS_SWIN + 1 * MiB;
constexpr size_t WS_END = WS_RSS + 1 * MiB;

namespace pg8 {
constexpr int BM = 256, BK = 64, HALF = 128, HTB = HALF * BK * 2, STAGE_BYTES = 8 * HTB, NXCD = 8, WGM = 8;
__host__ __device__ __forceinline__ int lds_byte(int r, int c) { const int st = (r >> 4) * 2 + (c >> 5), rr = r & 15, cc = c & 31, ob = rr * 64 + cc * 2; return st * 1024 + (ob ^ (((ob >> 9) & 1) << 5)); }
__host__ __device__ __forceinline__ void stage_rc(int b, int& R, int& C) { const int st = b / 1024, sb = b % 1024, swz = sb ^ (((sb >> 9) & 1) << 5); R = (st >> 1) * 16 + swz / 64; C = (st & 1) * 32 + (swz % 64) / 2; }

struct Unit { int pm, pn; };
struct Gemm { const bf16_t* A; const bf16_t* Bt; int K; };

struct Order {
    int nM, nN, nmain, nwg, G, c, nctx, lat0, ctx0, kvonly;
    int mode, offs, spm, spn;
    __device__ void init(int nlat_, int nctx_, int lat0_, int ctx0_, int N, int G_, int c_, int kvonly_ = 0) {
        nM = nlat_; nctx = nctx_; lat0 = lat0_; ctx0 = ctx0_; nN = N / BM; nmain = nM * nN; kvonly = kvonly_; nwg = nmain + nctx_ * (kvonly_ ? 5 : nN); G = G_; c = c_; mode = 0; offs = 0; spm = 0; spn = 0; }
    __device__ void main_unit(int m, Unit& u) const {
        const int q = nmain / NXCD, r = nmain % NXCD, xcd = m % NXCD, off = m / NXCD;
        const int wgid = (xcd < r ? xcd * (q + 1) : r * (q + 1) + (xcd - r) * q) + off;
        const int nig = WGM * nN, gid = wgid / nig, fm = gid * WGM, gsz = (nM - fm) < WGM ? (nM - fm) : WGM;
        u.pm = lat0 + fm + ((wgid % nig) % gsz); u.pn = (wgid % nig) / gsz;
    }
    __device__ bool next(int i, Unit& u) const {
        if (mode == 1) {
            const int L = i * G + c, nc = nctx * nN; if (L >= nwg) return false;
            if (L < nc) { u.pm = ctx0 + L % nctx; u.pn = L / nctx; } else main_unit(L - nc, u);
            return true;
        }
        if (mode == 2) {
            int L;
            if (i < 8) L = i * 256 + c; else if (c < 192 && i < 11) L = 2048 + (i - 8) * 192 + c; else if (c >= 192 && c < 224 && i == 8) L = 2624 + (c - 192); else return false;
            main_unit(offs + L, u); return true;
        }
        if (mode == 3) { if (i == 0 && c >= 192) { u.pm = spm; u.pn = spn; return true; } return false; }
        const long L = (long)i * G + c; if (L >= nwg) return false;
        int wgid = (int)L; { const int q = nwg / NXCD, r = nwg % NXCD, xcd = wgid % NXCD, off = wgid / NXCD; wgid = (xcd < r ? xcd * (q + 1) : r * (q + 1) + (xcd - r) * q) + off; }
        if (wgid < nmain) {
            const int nig = WGM * nN, gid = wgid / nig, fm = gid * WGM, gsz = (nM - fm) < WGM ? (nM - fm) : WGM;
            u.pm = lat0 + fm + ((wgid % nig) % gsz); u.pn = (wgid % nig) / gsz;
        } else {
            const int j = wgid - nmain, k = j / nctx;
            u.pm = ctx0 + j % nctx; u.pn = kvonly ? (int)((0x85432u >> (4 * k)) & 15u) : k;
        }
        return true;
    }
};

template <class Epi>
__device__ __forceinline__ void gemm_phase(LAS unsigned char* lds, const Gemm g, const Order& S, const Epi& E) {
    int tid = threadIdx.x; asm volatile("" : "+v"(tid));
    const int wid = __builtin_amdgcn_readfirstlane(tid >> 6), lane = tid & 63, wr = wid >> 2, wc = wid & 3, fr = lane & 15, fq = lane >> 4;
    const int K = g.K, nt = K / BK;
    unsigned voffA[2];
#pragma unroll
    for (int i = 0; i < 2; ++i) { int R, C; stage_rc(tid * 16 + i * 8192, R, C); voffA[i] = (unsigned)(R * K + C) * 2u; }
    const size_t kstep = (size_t)(BK * 2);
    const size_t hstep = (size_t)HALF * K * 2;
    const size_t tstep = 2 * hstep;
    const unsigned ldsw = (unsigned)wid * 1024u;
    const int aoff = lds_byte(wr * 64 + fr, fq * 8), boff = lds_byte(wc * 32 + fr, fq * 8);
#define PG8_SA(b, h) (((b) * 2 + (h)) * HTB)
#define PG8_SB(b, h) ((4 + (b) * 2 + (h)) * HTB)
#define PG8_STAGE(bufoff, gbase, voff) do { _Pragma("unroll") for (int _i = 0; _i < 2; ++_i) \
        __builtin_amdgcn_global_load_lds((const unsigned*)((const char*)(gbase) + (voff)[_i]), (LAS unsigned*)(lds + (bufoff) + ldsw + _i * 8192), 16, 0, 0); } while (0)
#define PG8_LDA(dst, b, h) do { _Pragma("unroll") for (int m = 0; m < 4; ++m) _Pragma("unroll") for (int k = 0; k < 2; ++k) dst[m][k] = *(const LAS bf16x8*)(lds + PG8_SA(b, h) + aoff + m * 2048 + k * 1024); } while (0)
#define PG8_LDB(dst, b, h) do { _Pragma("unroll") for (int n = 0; n < 2; ++n) _Pragma("unroll") for (int k = 0; k < 2; ++k) dst[n][k] = *(const LAS bf16x8*)(lds + PG8_SB(b, h) + boff + n * 2048 + k * 1024); } while (0)
#define PG8_MMA(ai, bj, At, Bt) do { __builtin_amdgcn_s_setprio(1); _Pragma("unroll") for (int m = 0; m < 4; ++m) _Pragma("unroll") for (int n = 0; n < 2; ++n) _Pragma("unroll") for (int k = 0; k < 2; ++k) \
        acc[ai][bj][m][n] = __builtin_amdgcn_mfma_f32_16x16x32_bf16(Bt[n][k], At[m][k], acc[ai][bj][m][n], 0, 0, 0); __builtin_amdgcn_s_setprio(0); } while (0)
#define PG8_WAIT_V(n) asm volatile("s_waitcnt vmcnt(" #n ")" ::: "memory")
#define PG8_WAIT_L(n) asm volatile("s_waitcnt lgkmcnt(" #n ")" ::: "memory")
#define PG8_BAR __builtin_amdgcn_s_barrier()
#define PG8_SCHED __builtin_amdgcn_sched_barrier(0)
    Unit cur, nxt; int ui = 0;
    if (!S.next(0, cur)) return;
    f32x4 acc[2][2][4][2];
#pragma unroll
    for (int a = 0; a < 2; ++a)
#pragma unroll
        for (int b = 0; b < 2; ++b)
#pragma unroll
            for (int m = 0; m < 4; ++m)
#pragma unroll
                for (int n = 0; n < 2; ++n) acc[a][b][m][n] = (f32x4){0.f, 0.f, 0.f, 0.f};
    bf16x8 At[4][2], B0[2][2], B1[2][2];
    const char* cA = (const char*)g.A + (size_t)cur.pm * tstep; const char* cB = (const char*)g.Bt + (size_t)cur.pn * tstep;
    PG8_STAGE(PG8_SB(0, 0), cB, voffA); PG8_STAGE(PG8_SB(0, 1), cB + hstep, voffA); PG8_STAGE(PG8_SA(0, 0), cA, voffA); PG8_STAGE(PG8_SA(0, 1), cA + hstep, voffA);
    if (wr == 1) PG8_BAR;
    PG8_WAIT_V(2); PG8_BAR;
    PG8_STAGE(PG8_SB(1, 0), cB + kstep, voffA); PG8_STAGE(PG8_SA(1, 0), cA + kstep, voffA); PG8_STAGE(PG8_SB(1, 1), cB + hstep + kstep, voffA);
    PG8_WAIT_V(6); PG8_BAR;
    for (;;) {
        const bool has_next = S.next(ui + 1, nxt);
        const char* nA = has_next ? (const char*)g.A + (size_t)nxt.pm * tstep : cA; const char* nB = has_next ? (const char*)g.Bt + (size_t)nxt.pn * tstep : cB;
        for (int t = 0; t < nt; t += 2) {
            if constexpr (Epi::HOOK) { if (t == 8 || t == 16) E.hook(acc, cur, t, wr, wc, fr, fq); }
            const bool last = (t == nt - 2);
            const char* a1 = cA + (size_t)(t + 1) * kstep;
            const char* a2 = last ? nA : cA + (size_t)(t + 2) * kstep; const char* b2 = last ? nB : cB + (size_t)(t + 2) * kstep;
            const char* a3 = a2 + kstep; const char* b3 = b2 + kstep;
            PG8_LDB(B0, 0, 0); PG8_LDB(B1, 0, 1); PG8_SCHED; PG8_LDA(At, 0, 0); PG8_STAGE(PG8_SA(1, 1), a1 + hstep, voffA);
            PG8_WAIT_V(8); PG8_WAIT_L(0); PG8_BAR; PG8_MMA(0, 0, At, B0); PG8_MMA(0, 1, At, B1); PG8_BAR; PG8_SCHED;
            PG8_LDA(At, 0, 1); PG8_STAGE(PG8_SB(0, 0), b2, voffA); PG8_STAGE(PG8_SB(0, 1), b2 + hstep, voffA); PG8_STAGE(PG8_SA(0, 0), a2, voffA);
            PG8_WAIT_V(8); PG8_WAIT_L(0); PG8_BAR; PG8_MMA(1, 0, At, B0); PG8_MMA(1, 1, At, B1); PG8_BAR; PG8_SCHED;
            PG8_LDB(B0, 1, 0); PG8_LDB(B1, 1, 1); PG8_SCHED; PG8_LDA(At, 1, 0); PG8_STAGE(PG8_SA(0, 1), a2 + hstep, voffA);
            PG8_WAIT_V(8); PG8_WAIT_L(0); PG8_BAR; PG8_MMA(0, 0, At, B0); PG8_MMA(0, 1, At, B1); PG8_BAR; PG8_SCHED;
            PG8_LDA(At, 1, 1); PG8_STAGE(PG8_SB(1, 0), b3, voffA); PG8_STAGE(PG8_SB(1, 1), b3 + hstep, voffA); PG8_STAGE(PG8_SA(1, 0), a3, voffA);
            PG8_WAIT_V(8); PG8_WAIT_L(0); PG8_BAR; PG8_MMA(1, 0, At, B0); PG8_MMA(1, 1, At, B1); PG8_BAR; PG8_SCHED;
        }
        if (wr == 0) PG8_BAR;
        E(acc, cur, wr, wc, fr, fq);
        if (!has_next) break;
#pragma unroll
        for (int a = 0; a < 2; ++a)
#pragma unroll
            for (int b = 0; b < 2; ++b)
#pragma unroll
                for (int m = 0; m < 4; ++m)
#pragma unroll
                    for (int n = 0; n < 2; ++n) acc[a][b][m][n] = (f32x4){0.f, 0.f, 0.f, 0.f};
        cur = nxt; cA = nA; cB = nB; ++ui;
        if (wr == 1) PG8_BAR;
    }
    PG8_WAIT_V(0);
    PG8_BAR;
#undef PG8_SA
#undef PG8_SB
#undef PG8_STAGE
#undef PG8_LDA
#undef PG8_LDB
#undef PG8_MMA
#undef PG8_WAIT_V
#undef PG8_WAIT_L
#undef PG8_BAR
#undef PG8_SCHED
}
}
using pg8::Unit;
typedef f32x4 Acc[2][2][4][2];

__device__ __forceinline__ f32x4 quad_transpose(f32x4 x, int ln) {
    const bool b0 = ln & 1, b1 = ln & 2;
    { const float r0 = sx(b0 ? x[0] : x[1], 1, ln), r1 = sx(b0 ? x[2] : x[3], 1, ln); if (b0) { x[0] = r0; x[2] = r1; } else { x[1] = r0; x[3] = r1; } }
    { const float r0 = sx(b1 ? x[0] : x[2], 2, ln), r1 = sx(b1 ? x[1] : x[3], 2, ln); if (b1) { x[0] = r0; x[1] = r1; } else { x[2] = r0; x[3] = r1; } }
    return x;
}
__device__ __forceinline__ int pi16(int k) { return ((k & 4) << 1) | ((k & 8) >> 1) | (k & 3); }

struct EpiIn {
    static constexpr bool HOOK = false;
    bf16_t *AQ, *BQ, *AK, *AV, *BK, *BV, *CB, *PB, *G;
    const float *cosT, *sinT, *qg, *kg;
    const float *rss, *sw;
    unsigned* qkmax;
    __device__ __forceinline__ void operator()(const Acc& acc, const Unit& u, int wr, int wc, int fr, int fq) const {
        asm volatile("" : "+v"(fr), "+v"(fq));
        const int pm = u.pm, pn = u.pn;
        const bool isctx = pm >= 128;
        int bl, posb, rowlb, tb;
        if (!isctx) { bl = (pm >> 3) & 7; tb = (pm & 7) * 256; posb = 256 + tb; rowlb = bl * 2048 + tb; }
        else { bl = (pm - 128) & 7; tb = 0; posb = 0; rowlb = 16384 + (pm - 128) * 256; }
        const int rbase = 64 * wr + fr;
        float rv[8]; f32x4 sw4[2][2];
#pragma unroll
        for (int g = 0; g < 8; ++g) rv[g] = 1.0f;
#pragma unroll
        for (int bj = 0; bj < 2; ++bj)
#pragma unroll
            for (int n = 0; n < 2; ++n) sw4[bj][n] = (f32x4){0.f, 0.f, 0.f, 0.f};
        if (rss) {
#pragma unroll
            for (int g = 0; g < 8; ++g) rv[g] = rsqrtf(rss[pm * 256 + 128 * (g >> 2) + 16 * (g & 3) + rbase] * (1.0f / D) + EPS);
            const float* swp = sw + (size_t)(isctx ? 16 : (pm >> 3)) * D_IN + pn * 256 + 32 * wc + 4 * fq;
#pragma unroll
            for (int bj = 0; bj < 2; ++bj)
#pragma unroll
                for (int n = 0; n < 2; ++n) sw4[bj][n] = *(const f32x4*)(swp + 128 * bj + 16 * n);
        }
#define AV_(ai, bj, m, n) (acc[ai][bj][m][n] * rv[(ai) * 4 + (m)] + sw4[bj][n])
        if (pn < 4 || (pn >= 6 && pn <= 8)) {
            const bool isq = (pn < 2) || (pn == 6) || (pn == 7);
            const bool isqk = pn < 4; float nmx = 0.f;
            const bool isv = (pn == 8) && (wc >= 2);
            const bool donorm = (pn >= 6) && !isv;
            const bool dorope = !isctx && !isv;
            const float* gn = (pn == 8) ? kg : qg;
            f32x4 g4[2][2];
#pragma unroll
            for (int bj = 0; bj < 2; ++bj)
#pragma unroll
                for (int n = 0; n < 2; ++n) g4[bj][n] = *(const f32x4*)(gn + 32 * bj + 16 * n + 4 * fq);
#pragma unroll
            for (int ai = 0; ai < 2; ++ai)
#pragma unroll
                for (int m = 0; m < 4; ++m) {
                    const int rr = 128 * ai + 16 * m + rbase, pos = posb + rr, t = tb + rr;
                    f32x4 v[2][2];
#pragma unroll
                    for (int bj = 0; bj < 2; ++bj)
#pragma unroll
                        for (int n = 0; n < 2; ++n) v[bj][n] = AV_(ai, bj, m, n);
                    if (donorm) {
                        float ss = 0.f;
#pragma unroll
                        for (int bj = 0; bj < 2; ++bj)
#pragma unroll
                            for (int n = 0; n < 2; ++n) { const f32x4 x = v[bj][n]; ss += (x[0] * x[0] + x[1] * x[1]) + (x[2] * x[2] + x[3] * x[3]); }
                        { const int ln = fq * 16 + fr; ss += sx(ss, 16, ln); ss += sx(ss, 32, ln); }
                        const float rinv = rsqrtf(ss * (1.0f / 64.0f) + EPS);
#pragma unroll
                        for (int bj = 0; bj < 2; ++bj)
#pragma unroll
                            for (int n = 0; n < 2; ++n) v[bj][n] = v[bj][n] * rinv * g4[bj][n];
                    }
                    if (dorope) {
#pragma unroll
                        for (int bj = 0; bj < 2; ++bj) {
                            const int pv = (bj == 0) ? (t >> 6) : (t & 63);
                            const f32x4 c4 = *(const f32x4*)(cosT + pv * 16 + 4 * fq), s4 = *(const f32x4*)(sinT + pv * 16 + 4 * fq);
                            const f32x4 x1 = v[bj][0], x2 = v[bj][1];
                            v[bj][0] = x1 * c4 - x2 * s4; v[bj][1] = x2 * c4 + x1 * s4;
                        }
                    }
                    if (isqk) {
                        const float sc_ = (pn < 2) ? QSCALE : 1.0f; float s2 = 0.f;
#pragma unroll
                        for (int bj = 0; bj < 2; ++bj)
#pragma unroll
                            for (int n = 0; n < 2; ++n) { const f32x4 x = v[bj][n] * sc_; s2 += (x[0] * x[0] + x[1] * x[1]) + (x[2] * x[2] + x[3] * x[3]); }
                        { const int ln = fq * 16 + fr; s2 += sx(s2, 16, ln); s2 += sx(s2, 32, ln); }
                        nmx = fmaxf(nmx, s2);
                    }
                    if (isq) {
                        const int slot = ((pn < 2) ? pn * 4 : (pn - 6) * 4) + wc;
                        bf16_t* base = ((pn < 2) ? AQ : BQ) + ((size_t)(bl * 8 + slot) * LK + pos) * 64 + 4 * fq;
#pragma unroll
                        for (int bj = 0; bj < 2; ++bj)
#pragma unroll
                            for (int n = 0; n < 2; ++n) st4(base + 32 * bj + 16 * n, v[bj][n] * QSCALE);
                    } else if (!isv) {
                        const int slot = (pn == 8) ? wc : (pn - 2) * 4 + wc, NS = (pn == 8) ? 2 : 8;
                        bf16_t* base = ((pn == 8) ? BK : AK) + ((size_t)(bl * NS + slot) * NT_LAT + (pos >> 6)) * 4096 + (pos & 63) * 8;
#pragma unroll
                        for (int bj = 0; bj < 2; ++bj)
#pragma unroll
                            for (int n = 0; n < 2; ++n) { const int d = 32 * bj + 16 * n + 4 * fq; st4(base + (d >> 3) * 512 + (d & 7), v[bj][n]); }
                    } else {
                        const int h = wc - 2, k = pos & 63, kq = (k >> 2) & 3, ln = fq * 16 + fr;
                        bf16_t* base = BV + ((size_t)(bl * 2 + h) * NT_LAT + (pos >> 6)) * 4096 + (2 * (k >> 4) + (kq & 1)) * 512 + 4 * (kq >> 1) + (4 * fq + (fr & 3)) * 8;
#pragma unroll
                        for (int bj = 0; bj < 2; ++bj)
#pragma unroll
                            for (int n = 0; n < 2; ++n) st4(base + (32 * bj + 16 * n) * 8, quad_transpose(v[bj][n], ln));
                    }
                }
            if (isqk) {
                const int ln = fq * 16 + fr;
                nmx = fmaxf(nmx, sx(nmx, 1, ln)); nmx = fmaxf(nmx, sx(nmx, 2, ln)); nmx = fmaxf(nmx, sx(nmx, 4, ln)); nmx = fmaxf(nmx, sx(nmx, 8, ln));
                if (ln == 0) atomicMax(qkmax + ((pn >> 1) * 16 + (isctx ? pm - 128 : (pm >> 3))) * 8 + (pn & 1) * 4 + wc, __float_as_uint(nmx));
            }
        } else if (pn == 4 || pn == 5) {
#pragma unroll
            for (int ai = 0; ai < 2; ++ai)
#pragma unroll
                for (int m = 0; m < 4; ++m) {
                    const int rr = 128 * ai + 16 * m + rbase, pos = posb + rr, k = pos & 63, kq = (k >> 2) & 3, ln = fq * 16 + fr;
#pragma unroll
                    for (int bj = 0; bj < 2; ++bj) {
                        const int head = (pn - 4) * 2 + bj;
                        bf16_t* base = AV + ((size_t)(bl * 4 + head) * NT_LAT + (pos >> 6)) * 8192 + (2 * (k >> 4) + (kq & 1)) * 1024 + 4 * (kq >> 1) + (32 * wc + 4 * fq + (fr & 3)) * 8;
#pragma unroll
                        for (int n = 0; n < 2; ++n) st4(base + 16 * n * 8, quad_transpose(AV_(ai, bj, m, n), ln));
                    }
                }
        } else if (pn <= 10) {
#pragma unroll
            for (int ai = 0; ai < 2; ++ai)
#pragma unroll
                for (int m = 0; m < 4; ++m) {
                    bf16_t* base = CB + (size_t)(rowlb + 128 * ai + 16 * m + rbase) * 512 + (pn - 9) * 256 + 32 * wc + 8 * fq;
#pragma unroll
                    for (int bj = 0; bj < 2; ++bj) st8(base + 128 * bj, AV_(ai, bj, m, 0), AV_(ai, bj, m, 1));
                }
        } else if (pn <= 14) {
#pragma unroll
            for (int ai = 0; ai < 2; ++ai)
#pragma unroll
                for (int m = 0; m < 4; ++m) {
                    bf16_t* base = PB + (size_t)(rowlb + 128 * ai + 16 * m + rbase) * 512 + (pn - 11) * 128 + 32 * wc + 8 * fq;
                    st8(base, AV_(ai, 0, m, 0) * AV_(ai, 1, m, 0), AV_(ai, 0, m, 1) * AV_(ai, 1, m, 1));
                }
        } else {
#pragma unroll
            for (int ai = 0; ai < 2; ++ai)
#pragma unroll
                for (int m = 0; m < 4; ++m) {
                    bf16_t* base = G + ((size_t)((rowlb >> 8) * 12 + (pn - 15)) * 8 + (wr * 4 + wc)) * 8192 + (fq * 16 + fr) * 8 + (ai * 4 + m) * 1024;
#pragma unroll
                    for (int bj = 0; bj < 2; ++bj) { const f32x4 z0 = AV_(ai, bj, m, 0), z1 = AV_(ai, bj, m, 1);
                        st8(base + bj * 512, (f32x4){sigmoidf_(z0[0]), sigmoidf_(z0[1]), sigmoidf_(z0[2]), sigmoidf_(z0[3])}, (f32x4){sigmoidf_(z1[0]), sigmoidf_(z1[1]), sigmoidf_(z1[2]), sigmoidf_(z1[3])}); }
                }
        }
    }
#undef AV_
};

struct EpiMerge {
    static constexpr bool HOOK = true;
    const bf16_t* G; bf16_t* MG; int half;
    __device__ __forceinline__ void hook(Acc& acc, const Unit& u, int t, int wr, int wc, int fr, int fq) const {
        asm volatile("" : "+v"(fr), "+v"(fq));
        const int br = (t >> 3) - 1;
        const bf16_t* pa = G + ((size_t)(u.pm * 12 + br * 4 + u.pn) * 8 + (wr * 4 + wc)) * 8192 + (fq * 16 + fr) * 8;
        const bf16_t* pb = pa + (size_t)4 * 512 * 128;
#pragma unroll
        for (int hb = 0; hb < 2; ++hb) {
            u32x4 ca[4][2], cb[4][2];
#pragma unroll
            for (int gg = 0; gg < 4; ++gg)
#pragma unroll
                for (int h = 0; h < 2; ++h) { ca[gg][h] = *(const u32x4*)(pa + ((hb * 4 + gg) * 2 + h) * 512); cb[gg][h] = *(const u32x4*)(pb + ((hb * 4 + gg) * 2 + h) * 512); }
#pragma unroll
            for (int gg = 0; gg < 4; ++gg)
#pragma unroll
                for (int q = 0; q < 4; ++q) {
                    const unsigned a0 = ca[gg][q >> 1][(q & 1) * 2], a1 = ca[gg][q >> 1][(q & 1) * 2 + 1], b0 = cb[gg][q >> 1][(q & 1) * 2], b1 = cb[gg][q >> 1][(q & 1) * 2 + 1];
                    f32x4 r; r[0] = bflo(a0) * __builtin_amdgcn_rcpf(bflo(b0)); r[1] = bfhi(a0) * __builtin_amdgcn_rcpf(bfhi(b0));
                    r[2] = bflo(a1) * __builtin_amdgcn_rcpf(bflo(b1)); r[3] = bfhi(a1) * __builtin_amdgcn_rcpf(bfhi(b1));
                    acc[hb][q >> 1][gg][q & 1] = acc[hb][q >> 1][gg][q & 1] * r;
                }
            asm volatile("" ::: "memory");
        }
    }
    __device__ __forceinline__ void operator()(const Acc& acc, const Unit& u, int wr, int wc, int fr, int fq) const {
        asm volatile("" : "+v"(fr), "+v"(fq));
        const int gpm = (u.pm < 64) ? 64 * half + u.pm : 128 + (u.pm - 64);
        const int cc = u.pn * 256 + 32 * wc + 8 * fq;
        const bf16_t* pc = G + ((size_t)(u.pm * 12 + 8 + u.pn) * 8 + (wr * 4 + wc)) * 8192 + (fq * 16 + fr) * 8;
        bf16_t* ob = MG + (size_t)(gpm * 256 + 64 * wr + fr) * 1024 + cc;
        u32x4 cg[8][2];
#pragma unroll
        for (int g = 0; g < 8; ++g)
#pragma unroll
            for (int h = 0; h < 2; ++h) cg[g][h] = *(const u32x4*)(pc + (g * 2 + h) * 512);
#pragma unroll
        for (int g = 0; g < 8; ++g) {
            const int ai = g >> 2, m = g & 3;
            bf16_t* orow = ob + (size_t)(128 * ai + 16 * m) * 1024;
#pragma unroll
            for (int h = 0; h < 2; ++h) { const u32x4 w = cg[g][h];
                const f32x4 g0 = {bflo(w[0]), bfhi(w[0]), bflo(w[1]), bfhi(w[1])}, g1 = {bflo(w[2]), bfhi(w[2]), bflo(w[3]), bfhi(w[3])};
                st8(orow + 128 * h, acc[ai][h][m][0] * g0, acc[ai][h][m][1] * g1); }
        }
    }
};

struct EpiRes {
    static constexpr bool HOOK = false;
    const float* base_lat; float* out_lat; const float* base_ctx; float* out_ctx; const float* gate;
    bf16_t* xa; const float* ng; const float* scl; float* rss;
    __device__ __forceinline__ void operator()(const Acc& acc, const Unit& u, int wr, int wc, int fr, int fq) const {
        asm volatile("" : "+v"(fr), "+v"(fq));
        const bool isctx = u.pm >= 128;
        const int colb = u.pn * 256 + 32 * wc + 4 * fq;
        const size_t off0 = (size_t)(64 * wr + fr) * 1024 + colb;
        const float* bs = (isctx ? base_ctx + (size_t)(u.pm - 128) * 256 * 1024 : base_lat + (size_t)u.pm * 256 * 1024) + off0;
        float* os = (isctx ? out_ctx + (size_t)(u.pm - 128) * 256 * 1024 : out_lat + (size_t)u.pm * 256 * 1024) + off0;
        const int b17 = isctx ? 16 : (u.pm >> 3);
        const float* gt = gate + (size_t)b17 * NMOD + colb;
        f32x4 g4[4], cb[4], nb[4], nm[4];
#pragma unroll
        for (int q = 0; q < 4; ++q) { g4[q] = *(const f32x4*)(gt + 128 * (q >> 1) + 16 * (q & 1)); cb[q] = *(const f32x4*)(bs + 128 * (q >> 1) + 16 * (q & 1)); }
        if (xa) {
#pragma unroll
            for (int q = 0; q < 4; ++q) nm[q] = *(const f32x4*)(ng + colb + 128 * (q >> 1) + 16 * (q & 1)) * (1.0f + *(const f32x4*)(scl + (size_t)b17 * NMOD + colb + 128 * (q >> 1) + 16 * (q & 1)));
        }
        bf16_t* xs = xa + (size_t)u.pm * 256 * 1024 + off0;
        float ss[8];
#pragma unroll
        for (int g = 0; g < 8; ++g) {
            const int ai = g >> 2, m = g & 3;
            if (g < 7) { const float* nbase = bs + (size_t)(128 * ((g + 1) >> 2) + 16 * ((g + 1) & 3)) * 1024;
#pragma unroll
                for (int q = 0; q < 4; ++q) nb[q] = *(const f32x4*)(nbase + 128 * (q >> 1) + 16 * (q & 1)); }
            float* orow = os + (size_t)(128 * ai + 16 * m) * 1024;
            float sq = 0.f;
#pragma unroll
            for (int q = 0; q < 4; ++q) {
                const f32x4 xn = cb[q] + g4[q] * acc[ai][q >> 1][m][q & 1];
                *(f32x4*)(orow + 128 * (q >> 1) + 16 * (q & 1)) = xn;
                if (xa) { st4(xs + (size_t)(128 * ai + 16 * m) * 1024 + 128 * (q >> 1) + 16 * (q & 1), xn * nm[q]); sq += (xn[0] * xn[0] + xn[1] * xn[1]) + (xn[2] * xn[2] + xn[3] * xn[3]); }
            }
            asm volatile("" : "+v"(sq));
            ss[g] = sq;
            asm volatile("" ::: "memory");
#pragma unroll
            for (int q = 0; q < 4; ++q) cb[q] = nb[q];
        }
        if (xa) {
            const int ln = fq * 16 + fr;
#pragma unroll
            for (int g = 0; g < 8; ++g) { float v = ss[g]; v += sx(v, 16, ln); v += sx(v, 32, ln);
                if (fq == 0) atomicAdd(rss + u.pm * 256 + 128 * (g >> 2) + 16 * (g & 3) + 64 * wr + fr, v); }
        }
    }
};

struct EpiGlu {
    static constexpr bool HOOK = false;
    bf16_t* H; const float *rss, *sw;
    __device__ __forceinline__ void operator()(const Acc& acc, const Unit& u, int wr, int wc, int fr, int fq) const {
        asm volatile("" : "+v"(fr), "+v"(fq));
        const float* swp = sw + (size_t)((u.pm >= 128) ? 16 : (u.pm >> 3)) * (2 * D_FF) + u.pn * 256 + 32 * wc + 4 * fq;
        f32x4 sg[2], su[2];
#pragma unroll
        for (int n = 0; n < 2; ++n) { sg[n] = *(const f32x4*)(swp + 16 * n); su[n] = *(const f32x4*)(swp + 128 + 16 * n); }
#pragma unroll
        for (int ai = 0; ai < 2; ++ai)
#pragma unroll
            for (int m = 0; m < 4; ++m) {
                const int row = u.pm * 256 + 128 * ai + 64 * wr + 16 * m + fr;
                const float rinv = rsqrtf(rss[row] * (1.0f / D) + EPS);
                bf16_t* base = H + (size_t)row * D_FF + u.pn * 128 + 32 * wc + 8 * fq;
                f32x4 hv[2];
#pragma unroll
                for (int n = 0; n < 2; ++n) { const f32x4 g = acc[ai][0][m][n] * rinv + sg[n], up = acc[ai][1][m][n] * rinv + su[n];
                    hv[n] = (f32x4){g[0] * sigmoidf_(g[0]) * up[0], g[1] * sigmoidf_(g[1]) * up[1], g[2] * sigmoidf_(g[2]) * up[2], g[3] * sigmoidf_(g[3]) * up[3]}; }
                st8(base, hv[0], hv[1]);
            }
    }
};

constexpr int A_K0 = 0, A_V0 = 24576, A_WSF = 73728, A_STG = 75776;
constexpr float THR = 6.0f;
__device__ __forceinline__ int crow(int r, int hi) { return (r & 3) + 8 * (r >> 2) + 4 * hi; }
__device__ __forceinline__ bf16x8 pack8(const f32x16& p, int b) {
    u32x4 w; w.x = pk2(p[b], p[b + 1]); w.y = pk2(p[b + 2], p[b + 3]); w.z = pk2(p[b + 4], p[b + 5]); w.w = pk2(p[b + 6], p[b + 7]);
    return __builtin_bit_cast(bf16x8, w);
}

template <int NDV, bool NOMAX>
__device__ __forceinline__ void attn_pass(const bf16_t* __restrict__ Qw, const char* __restrict__ Kt, const char* __restrict__ Vt, int nt, LAS unsigned char* lds, f32x16 (&o)[NDV]) {
    int tid = threadIdx.x; asm volatile("" : "+v"(tid));
    const int lane = tid & 63, r32 = lane & 31, hi = lane >> 5, wid = tid >> 6;
    constexpr int DV = NDV * 32, VT_BYTES = 64 * DV * 2, NVP = VT_BYTES / 8192;
    LAS float* wsf = (LAS float*)(lds + A_WSF + wid * 256);
    u32x4 kreg, vreg[NVP];
    const char* kg = Kt + tid * 16; const char* vg = Vt + tid * 16;
    LAS unsigned char* kl = lds + A_K0 + tid * 16; LAS unsigned char* vl = lds + A_V0 + tid * 16;
    const LAS unsigned char* kr = lds + A_K0 + hi * 1024 + r32 * 16;
    const LAS unsigned char* vr = lds + A_V0 + (hi * DV + r32) * 16;
#define AT_LOAD(j) do { kreg = *(const u32x4*)(kg + (size_t)(j) * 8192); _Pragma("unroll") for (int i_ = 0; i_ < NVP; ++i_) vreg[i_] = *(const u32x4*)(vg + (size_t)(j) * VT_BYTES + i_ * 8192); } while (0)
#define AT_STORE(slot) do { *(LAS u32x4*)(kl + (slot) * 8192) = kreg; _Pragma("unroll") for (int i_ = 0; i_ < NVP; ++i_) *(LAS u32x4*)(vl + (slot) * 16384 + i_ * 8192) = vreg[i_]; } while (0)
#define AT_QK(P0, P1, slot) do { const LAS unsigned char* kb_ = kr + (slot) * 8192; P0 = negm; P1 = negm; \
        _Pragma("unroll") for (int d0 = 0; d0 < 4; ++d0) { const bf16x8 k0_ = *(const LAS bf16x8*)(kb_ + d0 * 2048), k1_ = *(const LAS bf16x8*)(kb_ + d0 * 2048 + 512); \
            P0 = __builtin_amdgcn_mfma_f32_32x32x16_bf16(k0_, qr[d0], P0, 0, 0, 0); P1 = __builtin_amdgcn_mfma_f32_32x32x16_bf16(k1_, qr[d0], P1, 0, 0, 0); } } while (0)
#define AT_EXP(P0, P1) do { float ps_ = 0.f; _Pragma("unroll") for (int r = 0; r < 16; ++r) { P0[r] = __builtin_amdgcn_exp2f(P0[r]); P1[r] = __builtin_amdgcn_exp2f(P1[r]); ps_ += P0[r] + P1[r]; } l += ps_; \
        pa[0] = pack8(P0, 0); pa[1] = pack8(P0, 8); pa[2] = pack8(P1, 0); pa[3] = pack8(P1, 8); } while (0)
#define AT_PV(slot) do { const LAS unsigned char* vb_ = vr + (slot) * 16384; __builtin_amdgcn_s_setprio(1); \
        _Pragma("unroll") for (int d0 = 0; d0 < NDV; ++d0) _Pragma("unroll") for (int s_ = 0; s_ < 4; ++s_) { const bf16x8 v_ = *(const LAS bf16x8*)(vb_ + s_ * (2 * DV * 16) + d0 * 512); \
            o[d0] = __builtin_amdgcn_mfma_f32_32x32x16_bf16(pa[s_], v_, o[d0], 0, 0, 0); } __builtin_amdgcn_s_setprio(0); } while (0)
#define AT_MAX(P0, P1) do { if (NOMAX) break; float rm_ = fmaxf(P0[0], P1[0]); _Pragma("unroll") for (int r = 1; r < 16; ++r) rm_ = fmaxf(rm_, fmaxf(P0[r], P1[r])); rm_ = fmaxf(rm_, sx(rm_, 32, lane)); \
        if (__any(rm_ > THR)) { const float dl_ = fmaxf(rm_, 0.f); mref += dl_; _Pragma("unroll") for (int r = 0; r < 16; ++r) { P0[r] -= dl_; P1[r] -= dl_; negm[r] = -mref; } \
            const float f_ = __builtin_amdgcn_exp2f(-dl_); l *= f_; if (hi == 0) wsf[r32] = f_; \
            _Pragma("unroll") for (int r = 0; r < 16; ++r) { const float fr_ = wsf[crow(r, hi)]; _Pragma("unroll") for (int d0 = 0; d0 < NDV; ++d0) o[d0][r] *= fr_; } } } while (0)
    AT_LOAD(0);
    bf16x8 qr[4];
#pragma unroll
    for (int d0 = 0; d0 < 4; ++d0) qr[d0] = *(const bf16x8*)(Qw + r32 * 64 + d0 * 16 + hi * 8);
    AT_STORE(0);
    AT_LOAD(1);
    AT_STORE(1);
    if (nt > 2) AT_LOAD(2);
    __syncthreads();
    float mref = 0.f, l = 0.f;
#pragma unroll
    for (int d0 = 0; d0 < NDV; ++d0)
#pragma unroll
        for (int r = 0; r < 16; ++r) o[d0][r] = 0.f;
    f32x16 negm;
#pragma unroll
    for (int r = 0; r < 16; ++r) negm[r] = 0.f;
    f32x16 pA0, pA1, pB0, pB1; bf16x8 pa[4];
    AT_QK(pA0, pA1, 0);
    if (!NOMAX) {
        float rm = fmaxf(pA0[0], pA1[0]);
#pragma unroll
        for (int r = 1; r < 16; ++r) rm = fmaxf(rm, fmaxf(pA0[r], pA1[r]));
        rm = fmaxf(rm, sx(rm, 32, lane));
        mref = rm;
#pragma unroll
        for (int r = 0; r < 16; ++r) { pA0[r] -= rm; pA1[r] -= rm; negm[r] = -mref; }
    }
    int s0 = 0, s1 = 1, s2 = 2;
#define AT_ROT() do { const int t_ = s0; s0 = s1; s1 = s2; s2 = t_; } while (0)
#define AT_STEP(C0, C1, N0, N1, t, HAS2, HAS3) do { \
        AT_QK(N0, N1, s1); \
        AT_EXP(C0, C1); \
        AT_PV(s0); \
        AT_MAX(N0, N1); \
        if (HAS2) AT_STORE(s2); \
        if (HAS3) AT_LOAD((t) + 3); \
        __syncthreads(); AT_ROT(); } while (0)
    int t = 0;
    for (; t + 4 <= nt - 2; t += 2) {
        AT_STEP(pA0, pA1, pB0, pB1, t, true, true);
        AT_STEP(pB0, pB1, pA0, pA1, t + 1, true, true);
    }
    AT_STEP(pA0, pA1, pB0, pB1, t, true, (t + 3 < nt));
    AT_STEP(pB0, pB1, pA0, pA1, t + 1, (t + 3 < nt), false);
    t += 2;
    for (; t + 2 <= nt - 2; t += 2) { }
    AT_STEP(pA0, pA1, pB0, pB1, t, false, false);
    AT_EXP(pB0, pB1);
    AT_PV(s0);
    __syncthreads();
    l += sx(l, 32, lane);
    const float li = 1.0f / l;
    if (hi == 0) wsf[r32] = li;
#pragma unroll
    for (int r = 0; r < 16; ++r) { const float s = wsf[crow(r, hi)];
#pragma unroll
        for (int d0 = 0; d0 < NDV; ++d0) o[d0][r] *= s; }
#undef AT_LOAD
#undef AT_STORE
#undef AT_QK
#undef AT_EXP
#undef AT_PV
#undef AT_MAX
#undef AT_ROT
#undef AT_STEP
}

template <int NDV, bool FIXED>
__device__ __forceinline__ void attn_pass_simple(const bf16_t* __restrict__ Qw, const char* __restrict__ Kt, const char* __restrict__ Vt, int nt, LAS unsigned char* lds, f32x16 (&o)[NDV], float kmax2) {
    int tid = threadIdx.x; asm volatile("" : "+v"(tid));
    const int lane = tid & 63, r32 = lane & 31, hi = lane >> 5, wid = tid >> 6;
    constexpr int DV = NDV * 32, VT_BYTES = 64 * DV * 2, NVP = VT_BYTES / 8192;
    LAS float* wsf = (LAS float*)(lds + A_WSF + wid * 256);
    u32x4 kreg, vreg[NVP];
    kreg = *(const u32x4*)(Kt + tid * 16);
#pragma unroll
    for (int i = 0; i < NVP; ++i) vreg[i] = *(const u32x4*)(Vt + (i * 512 + tid) * 16);
    bf16x8 qr[4];
#pragma unroll
    for (int d0 = 0; d0 < 4; ++d0) qr[d0] = *(const bf16x8*)(Qw + r32 * 64 + d0 * 16 + hi * 8);
    *(LAS u32x4*)(lds + A_K0 + tid * 16) = kreg;
#pragma unroll
    for (int i = 0; i < NVP; ++i) *(LAS u32x4*)(lds + A_V0 + (i * 512 + tid) * 16) = vreg[i];
    __syncthreads();
    float mref = 0.f, l = 0.f;
#pragma unroll
    for (int d0 = 0; d0 < NDV; ++d0)
#pragma unroll
        for (int r = 0; r < 16; ++r) o[d0][r] = 0.f;
    f32x16 negm;
#pragma unroll
    for (int r = 0; r < 16; ++r) negm[r] = 0.f;
    if (FIXED) {
        float qn2 = 0.f;
#pragma unroll
        for (int d0 = 0; d0 < 4; ++d0) { const u32x4 w = __builtin_bit_cast(u32x4, qr[d0]);
#pragma unroll
            for (int e = 0; e < 4; ++e) { const float a = bflo(w[e]), b = bfhi(w[e]); qn2 += a * a + b * b; } }
        qn2 += sx(qn2, 32, lane);
        mref = sqrtf(qn2 * kmax2) * 1.02f + 0.5f;
#pragma unroll
        for (int r = 0; r < 16; ++r) negm[r] = -mref;
    }
    for (int t = 0; t < nt; ++t) {
        const int cur = t & 1;
        const bool more = (t + 1 < nt);
        if (more) {
            kreg = *(const u32x4*)(Kt + (size_t)(t + 1) * 8192 + tid * 16);
#pragma unroll
            for (int i = 0; i < NVP; ++i) vreg[i] = *(const u32x4*)(Vt + (size_t)(t + 1) * VT_BYTES + (i * 512 + tid) * 16);
        }
        const LAS unsigned char* kb = lds + A_K0 + cur * 8192 + hi * 1024 + r32 * 16;
        f32x16 p0 = negm, p1 = negm;
        __builtin_amdgcn_s_setprio(1);
#pragma unroll
        for (int d0 = 0; d0 < 4; ++d0) {
            const bf16x8 k0 = *(const LAS bf16x8*)(kb + d0 * 2048), k1 = *(const LAS bf16x8*)(kb + d0 * 2048 + 512);
            p0 = __builtin_amdgcn_mfma_f32_32x32x16_bf16(k0, qr[d0], p0, 0, 0, 0);
            p1 = __builtin_amdgcn_mfma_f32_32x32x16_bf16(k1, qr[d0], p1, 0, 0, 0);
        }
        __builtin_amdgcn_s_setprio(0);
        if (!FIXED) {
        float rm = fmaxf(p0[0], p1[0]);
#pragma unroll
        for (int r = 1; r < 16; ++r) rm = fmaxf(rm, fmaxf(p0[r], p1[r]));
        rm = fmaxf(rm, sx(rm, 32, lane));
        if (t == 0) {
            mref = rm;
#pragma unroll
            for (int r = 0; r < 16; ++r) { p0[r] -= rm; p1[r] -= rm; negm[r] = -mref; }
        } else if (__any(rm > THR)) {
            const float dl = fmaxf(rm, 0.f);
            mref += dl;
#pragma unroll
            for (int r = 0; r < 16; ++r) { p0[r] -= dl; p1[r] -= dl; negm[r] = -mref; }
            const float f = __builtin_amdgcn_exp2f(-dl);
            l *= f;
            if (hi == 0) wsf[r32] = f;
#pragma unroll
            for (int r = 0; r < 16; ++r) { const float fr_ = wsf[crow(r, hi)];
#pragma unroll
                for (int d0 = 0; d0 < NDV; ++d0) o[d0][r] *= fr_; }
        }
        }
        float ps = 0.f;
#pragma unroll
        for (int r = 0; r < 16; ++r) { p0[r] = __builtin_amdgcn_exp2f(p0[r]); p1[r] = __builtin_amdgcn_exp2f(p1[r]); ps += p0[r] + p1[r]; }
        l += ps;
        bf16x8 pa[4];
        pa[0] = pack8(p0, 0); pa[1] = pack8(p0, 8); pa[2] = pack8(p1, 0); pa[3] = pack8(p1, 8);
        const LAS unsigned char* vb = lds + A_V0 + cur * 16384 + (hi * DV + r32) * 16;
        __builtin_amdgcn_s_setprio(1);
#pragma unroll
        for (int d0 = 0; d0 < NDV; ++d0)
#pragma unroll
            for (int s = 0; s < 4; ++s) {
                const bf16x8 v = *(const LAS bf16x8*)(vb + s * (2 * DV * 16) + d0 * 512);
                o[d0] = __builtin_amdgcn_mfma_f32_32x32x16_bf16(pa[s], v, o[d0], 0, 0, 0);
            }
        __builtin_amdgcn_s_setprio(0);
        if (more) {
            *(LAS u32x4*)(lds + A_K0 + (cur ^ 1) * 8192 + tid * 16) = kreg;
#pragma unroll
            for (int i = 0; i < NVP; ++i) *(LAS u32x4*)(lds + A_V0 + (cur ^ 1) * 16384 + (i * 512 + tid) * 16) = vreg[i];
        }
        __syncthreads();
    }
    l += sx(l, 32, lane);
    const float li = 1.0f / l;
    if (hi == 0) wsf[r32] = li;
#pragma unroll
    for (int r = 0; r < 16; ++r) { const float s = wsf[crow(r, hi)];
#pragma unroll
        for (int d0 = 0; d0 < NDV; ++d0) o[d0][r] *= s; }
}

struct Params {
    const float *x, *c, *ctx, *c_ctx, *w_mod, *b_mod, *norm1_g, *norm2_g, *w_in, *lam_q1, *lam_k1, *lam_q2, *lam_k2, *subln_g, *q_norm_g, *k_norm_g, *conv_w,
        *w_a, *w_b, *w_c, *w_out, *w_gu, *w_dn, *final_g;
    float* out; unsigned char* ws;
    int use_cg; int pad;
};

__device__ __forceinline__ int rowmap(int kind, int c) {
    if (kind == 1) {
        if (c < 1024 || (c >= 1536 && c < 2304)) { const int unit = c >> 8, lc = c & 255, chunk = lc >> 6, d = lc & 63; return (unit << 8) + ((d >> 5) << 7) + (chunk << 5) + (d & 31); }
        if (c >= 2816 && c < 3840) { const int isu = (c >= 3328) ? 1 : 0; const int ch = c - (isu ? 3328 : 2816); return 2816 + ((ch >> 7) << 8) + (isu << 7) + ((ch & 127) & ~31) + ip32(ch & 31); }
        if (c >= 2304) return (c & ~31) + ip32(c & 31);
        return c;
    }
    if (kind == 2) {
        const int isu = (c >= D_FF) ? 1 : 0; const int j = c - (isu ? D_FF : 0); return ((j >> 7) << 8) + (isu << 7) + ((j & 127) & ~31) + ip32(j & 31);
    }
    if (kind == 3) return (c & ~31) + ip32(c & 31);
    return c;
}
__device__ __forceinline__ void transpose_item(const float* __restrict__ W, int N, bf16_t* WT, int ldk, int koff, int kind, LAS float* scr, int item, int lane) {
    const int nblk = N / 32, kb = item / nblk, nb = item % nblk, k0 = 64 * kb, n0 = 32 * nb;
    f32x4 tv[8];
#pragma unroll
    for (int i = 0; i < 8; ++i) tv[i] = *(const f32x4*)(W + (size_t)(k0 + (lane >> 3) + 8 * i) * N + n0 + (lane & 7) * 4);
#pragma unroll
    for (int i = 0; i < 8; ++i) { LAS float* d = scr + ((lane >> 3) + 8 * i) * 33 + (lane & 7) * 4; d[0] = tv[i][0]; d[1] = tv[i][1]; d[2] = tv[i][2]; d[3] = tv[i][3]; }
    asm volatile("s_waitcnt lgkmcnt(0)" ::: "memory");
    const int c = lane & 7;
#pragma unroll
    for (int j = 0; j < 4; ++j) { const int n = (lane >> 3) + 8 * j; const LAS float* s = scr + (8 * c) * 33 + n;
        u32x4 o; o.x = pk2(s[0 * 33], s[1 * 33]); o.y = pk2(s[2 * 33], s[3 * 33]); o.z = pk2(s[4 * 33], s[5 * 33]); o.w = pk2(s[6 * 33], s[7 * 33]);
        *(u32x4*)(WT + (size_t)rowmap(kind, n0 + n) * ldk + koff + k0 + 8 * c) = o; }
    asm volatile("s_waitcnt lgkmcnt(0)" ::: "memory");
}
__device__ __forceinline__ float wave_sum(float v, int lane) {
#pragma unroll
    for (int o = 1; o < 64; o <<= 1) v += sx(v, o, lane);
    return v;
}
__device__ __forceinline__ void norm_mod_row(const float* xrow, const float* g, const float* shift, const float* scale, bf16_t* orow, int lane) {
    f32x4 v[4]; float s = 0.f;
#pragma unroll
    for (int j = 0; j < 4; ++j) { v[j] = *(const f32x4*)(xrow + 4 * lane + 256 * j); s += (v[j][0] * v[j][0] + v[j][1] * v[j][1]) + (v[j][2] * v[j][2] + v[j][3] * v[j][3]); }
    const float rinv = rsqrtf(wave_sum(s, lane) * (1.0f / D) + EPS);
#pragma unroll
    for (int j = 0; j < 4; ++j) {
        const f32x4 gg = *(const f32x4*)(g + 4 * lane + 256 * j), sh = *(const f32x4*)(shift + 4 * lane + 256 * j), sc = *(const f32x4*)(scale + 4 * lane + 256 * j);
        st4(orow + 4 * lane + 256 * j, (v[j] * rinv * gg) * (1.0f + sc) + sh);
    }
}

__device__ __forceinline__ void transpose_layer(const Params& P, unsigned char* ws, int l, int gw, int NGW, LAS float* scr, int lane) {
    constexpr int I_IN = 16 * 216, I_BR = 8 * 32, I_OUT = 16 * 32, I_GU = 16 * 176, I_DN = 44 * 32;
    constexpr int I_LAYER = I_IN + 3 * I_BR + I_OUT + I_GU + I_DN;
    unsigned char* wt = ws + (size_t)l * WT_LAYER;
    for (int it = gw; it < I_LAYER; it += NGW) {
        int r = it;
        if (r < I_IN) { transpose_item(P.w_in + (size_t)l * D * D_IN, D_IN, (bf16_t*)(wt + OFF_WIN), D, 0, 1, scr, r, lane); continue; } r -= I_IN;
        if (r < I_BR) { transpose_item(P.w_a + (size_t)l * 512 * D, D, (bf16_t*)(wt + OFF_WBR), 1536, 0, 3, scr, r, lane); continue; } r -= I_BR;
        if (r < I_BR) { transpose_item(P.w_b + (size_t)l * 512 * D, D, (bf16_t*)(wt + OFF_WBR), 1536, 512, 3, scr, r, lane); continue; } r -= I_BR;
        if (r < I_BR) { transpose_item(P.w_c + (size_t)l * 512 * D, D, (bf16_t*)(wt + OFF_WBR), 1536, 1024, 3, scr, r, lane); continue; } r -= I_BR;
        if (r < I_OUT) { transpose_item(P.w_out + (size_t)l * D * D, D, (bf16_t*)(wt + OFF_WOUT), D, 0, 0, scr, r, lane); continue; } r -= I_OUT;
        if (r < I_GU) { transpose_item(P.w_gu + (size_t)l * D * 2 * D_FF, 2 * D_FF, (bf16_t*)(wt + OFF_WGU), D, 0, 2, scr, r, lane); continue; } r -= I_GU;
        transpose_item(P.w_dn + (size_t)l * D_FF * D, D, (bf16_t*)(wt + OFF_WDN), D_FF, 0, 0, scr, r, lane);
    }
}
__device__ __forceinline__ void sw_sets(unsigned char* ws, const float* MOD, float* SWIN, float* SWGU, int set_lo, int set_hi, int vw, int nvw, LAS unsigned char* lds, int tid, int lane) {
    LAS float* S = (LAS float*)lds;
    for (int set = set_lo; set < set_hi; ++set) {
        const int ls = (set == 0) ? 0 : 1, idx = (set == 1) ? 0 : 3, ncols = (set == 1) ? D_IN : 2 * D_FF;
        const bf16_t* W = (const bf16_t*)(ws + (size_t)ls * WT_LAYER + ((set == 1) ? OFF_WIN : OFF_WGU));
        float* outp = (set == 1) ? SWIN : SWGU + (size_t)ls * 17 * (2 * D_FF);
        for (int i = tid; i < 17 * 1024; i += 512) S[i] = MOD[(size_t)(ls * 17 + (i >> 10)) * NMOD + idx * 1024 + (i & 1023)];
        __syncthreads();
        for (int c = vw; c < ncols; c += nvw) {
            const bf16_t* wrow = W + (size_t)c * 1024 + lane * 16;
            const u32x4 w0 = *(const u32x4*)wrow, w1 = *(const u32x4*)(wrow + 8);
            float wv[16];
#pragma unroll
            for (int q = 0; q < 4; ++q) { wv[2 * q] = bflo(w0[q]); wv[2 * q + 1] = bfhi(w0[q]); wv[8 + 2 * q] = bflo(w1[q]); wv[8 + 2 * q + 1] = bfhi(w1[q]); }
#pragma unroll 1
            for (int r = 0; r < 17; ++r) {
                float a = 0.f;
#pragma unroll
                for (int q = 0; q < 4; ++q) { const f32x4 sv = *(const LAS f32x4*)(S + r * 1024 + lane * 16 + 4 * q); a += (sv[0] * wv[4 * q] + sv[1] * wv[4 * q + 1]) + (sv[2] * wv[4 * q + 2] + sv[3] * wv[4 * q + 3]); }
                a = wave_sum(a, lane);
                if (lane == 0) outp[(size_t)r * ncols + c] = a;
            }
        }
        __syncthreads();
    }
}

#define XB_TMO      128
#define XB_XCNT(j)  (256  + 64 * (j))
#define XB_XSUB(j)  (1280 + 64 * (j))
#define XB_XGEN(j)  (2304 + 64 * (j))
#define XB_TOP      3328
#define XB_TOPGEN   3392
#define XCD_BAR_WORDS 3456
#define XB_SPIN_CAP (1u << 18)
__device__ __forceinline__ unsigned xb_ld(unsigned* p)              { return __hip_atomic_load(p, __ATOMIC_RELAXED, __HIP_MEMORY_SCOPE_AGENT); }
__device__ __forceinline__ unsigned xb_add(unsigned* p, unsigned v) { return __hip_atomic_fetch_add(p, v, __ATOMIC_RELAXED, __HIP_MEMORY_SCOPE_AGENT); }
__device__ __forceinline__ unsigned xb_xcc_id() { return (unsigned)__builtin_amdgcn_s_getreg((3 << 11) | 20) & 0xFu; }
#define XB_SPIN(cond, bar) do { unsigned _sp = 0; while (cond) { __builtin_amdgcn_s_sleep(1); \
    if ((++_sp & 255u) == 0u) { if (xb_ld(&(bar)[XB_TMO])) break; if (_sp > XB_SPIN_CAP) { atomicAdd(&(bar)[XB_TMO], 1u); break; } } } } while (0)
struct XcdBarrier { unsigned* bar; unsigned x; volatile LAS unsigned* st; };
__device__ __forceinline__ XcdBarrier xcd_barrier_post(unsigned* bar, volatile LAS unsigned* st) {
    XcdBarrier b; b.bar = bar; b.x = xb_xcc_id(); b.st = st;
    if (threadIdx.x == 0) (void)xb_add(&bar[XB_XCNT(b.x)], 1u);
    return b;
}
__device__ __forceinline__ void xcd_barrier_complete(unsigned* bar, unsigned x, unsigned& nloc, unsigned& nx) {
    const unsigned G = gridDim.x * gridDim.y * gridDim.z;
    unsigned sum, cnt, mine, sp = 0u;
    for (;;) {
        sum = 0u; cnt = 0u; mine = 0u;
#pragma unroll
        for (unsigned j = 0; j < 16; ++j) { const unsigned c = xb_ld(&bar[XB_XCNT(j)]); sum += c; cnt += (c > 0u) ? 1u : 0u; mine = (j == x) ? c : mine; }
        if (sum == G) break;
        __builtin_amdgcn_s_sleep(1);
        if ((++sp & 255u) == 0u) { if (xb_ld(&bar[XB_TMO])) break; if (sp > XB_SPIN_CAP) { atomicAdd(&bar[XB_TMO], 1u); break; } }
    }
    nloc = mine > 0u ? mine : 1u; nx = cnt > 0u ? cnt : 1u;
}
__device__ __forceinline__ void xcd_barrier(const XcdBarrier& b) {
    asm volatile("s_waitcnt vmcnt(0)" ::: "memory");
    __syncthreads();
    if (threadIdx.x == 0) {
        unsigned* bar = b.bar;
        __builtin_amdgcn_s_waitcnt(0);
        unsigned nloc = b.st[0], nx = b.st[1];
        if (nloc == 0u) { xcd_barrier_complete(bar, b.x, nloc, nx); b.st[0] = nloc; b.st[1] = nx; }
        const unsigned old = xb_add(&bar[XB_XSUB(b.x)], 1u);
        const unsigned gen = old / nloc;
        if (old + 1u == (gen + 1u) * nloc) {
            __builtin_amdgcn_fence(__ATOMIC_RELEASE, "agent");
            asm volatile("s_waitcnt vmcnt(0)" ::: "memory");
            const unsigned og = xb_add(&bar[XB_TOP], 1u);
            const unsigned tg = og / nx;
            if (og + 1u == (tg + 1u) * nx) xb_add(&bar[XB_TOPGEN], 1u);
            else XB_SPIN(xb_ld(&bar[XB_TOPGEN]) == tg, bar);
            __builtin_amdgcn_fence(__ATOMIC_ACQUIRE, "agent");
            xb_add(&bar[XB_XGEN(b.x)], 1u);
            asm volatile("s_waitcnt vmcnt(0)" ::: "memory");
        } else {
            XB_SPIN(xb_ld(&bar[XB_XGEN(b.x)]) == gen, bar);
            __builtin_amdgcn_fence(__ATOMIC_ACQUIRE, "agent");
            asm volatile("s_waitcnt vmcnt(0)" ::: "memory");
        }
    }
    __syncthreads();
}

constexpr int LDS_BYTES = 147456;
#ifndef PHASE_MASK
#define PHASE_MASK 0xffff
#endif
#define PHASE_ON(k) (((PHASE_MASK) >> (k)) & 1)
#ifndef ATT_REP
#define ATT_REP 1
#endif
#ifndef P1_REP
#define P1_REP 1
#endif

__global__ void __launch_bounds__(512) fwd_kernel(Params P) {
    extern __shared__ __attribute__((aligned(16))) unsigned char lds_raw[];
    LAS unsigned char* lds = (LAS unsigned char*)lds_raw;
    cg::grid_group grid = cg::this_grid();
    const int G = gridDim.x, bx = blockIdx.x;
    const int vcu = (G % 8 == 0) ? (bx % 8) * (G / 8) + bx / 8 : bx;
    unsigned char* ws = P.ws;
    float* MOD = (float*)(ws + WS_MOD);
    float* cosT = (float*)(ws + WS_ROPE); float* sinT = cosT + 1024;
    float* CTXS = (float*)(ws + WS_CTXS);
    bf16_t* XN = (bf16_t*)(ws + WS_XN);
    bf16_t *AQ = (bf16_t*)(ws + B_AQ), *BQ = (bf16_t*)(ws + B_BQ), *AK = (bf16_t*)(ws + B_AK), *AV = (bf16_t*)(ws + B_AV), *BK = (bf16_t*)(ws + B_BK), *BV = (bf16_t*)(ws + B_BV);
    bf16_t *CB = (bf16_t*)(ws + B_CB), *PB = (bf16_t*)(ws + B_PB), *GT = (bf16_t*)(ws + B_G), *Y = (bf16_t*)(ws + B_Y);
    float* SCR = (float*)(ws + B_SCR);
    bf16_t *XN2 = (bf16_t*)(ws + B_XN2), *HB = (bf16_t*)(ws + B_H);
    float *SWGU = (float*)(ws + WS_SWGU), *SWIN = (float*)(ws + WS_SWIN), *RSS = (float*)(ws + WS_RSS);
    unsigned* QKMAX = (unsigned*)(ws + WS_RSS + 960 * 1024);

    unsigned* barw = (unsigned*)(ws + WS_BAR);
    volatile LAS unsigned* bst = (volatile LAS unsigned*)(lds + LDS_BYTES - 64);
    if (threadIdx.x < 2) bst[threadIdx.x] = 0u;
    for (int i = bx * 512 + threadIdx.x; i < 3 * M_ALL; i += G * 512) RSS[i] = 0.f;
    if (bx == 0) QKMAX[threadIdx.x] = 0u;
    __syncthreads();
    const XcdBarrier xbar = xcd_barrier_post(barw, bst);
#define GSYNC() xcd_barrier(xbar)
    {
        int tid = threadIdx.x; asm volatile("" : "+v"(tid)); const int lane = tid & 63, wid = __builtin_amdgcn_readfirstlane(tid >> 6); (void)lane; (void)wid;
        if (PHASE_ON(0)) {
        transpose_layer(P, ws, 0, vcu * 8 + wid, G * 8, (LAS float*)(lds + wid * 16384), lane);
        __syncthreads();
        if (bx < 192) {
            LAS float* S = (LAS float*)lds;
            for (int i = tid; i < 17 * 1024; i += 512) { const float v = (i < 16384) ? P.c[i] : P.c_ctx[i - 16384]; S[i] = v * sigmoidf_(v); }
            __syncthreads();
            const int l = bx / 96, n0 = (bx % 96) * 64;
            const float* Wm = P.w_mod + (size_t)l * D * NMOD + n0 + lane;
            float a17[17];
#pragma unroll
            for (int r = 0; r < 17; ++r) a17[r] = 0.f;
            for (int k = wid * 128; k < wid * 128 + 128; k += 4) {
                const float w0 = Wm[(size_t)k * NMOD], w1 = Wm[(size_t)(k + 1) * NMOD], w2 = Wm[(size_t)(k + 2) * NMOD], w3 = Wm[(size_t)(k + 3) * NMOD];
#pragma unroll
                for (int r = 0; r < 17; ++r) { const f32x4 s = *(const LAS f32x4*)(S + r * 1024 + k); a17[r] += (s[0] * w0 + s[1] * w1) + (s[2] * w2 + s[3] * w3); }
            }
            LAS float* R = (LAS float*)(lds + 69632);
#pragma unroll
            for (int r = 0; r < 17; ++r) R[(wid * 17 + r) * 64 + lane] = a17[r];
            __syncthreads();
            for (int i = tid; i < 17 * 64; i += 512) { const int r = i >> 6, col = i & 63; float s = 0.f;
#pragma unroll
                for (int w = 0; w < 8; ++w) s += R[(w * 17 + r) * 64 + col];
                MOD[(size_t)(l * 17 + r) * NMOD + n0 + col] = s + P.b_mod[l * NMOD + n0 + col]; }
            __syncthreads();
        }
        if (bx == G - 1) {
            for (int i = tid; i < 1024; i += 512) {
                const int pos = i >> 4, f = i & 15;
                const float inv = exp2f(-(float)f * (13.287712379549449f / 16.0f));
                const float ang = (float)pos * inv;
                const double xd = (double)ang, nn = __builtin_rint(xd * 0.63661977236758134308), r = (xd - nn * 1.57079632679489655800) - nn * 6.123233995736766e-17, r2 = r * r;
                const double sn = r * (1.0 + r2 * (-1.0 / 6 + r2 * (1.0 / 120 + r2 * (-1.0 / 5040 + r2 * (1.0 / 362880 + r2 * (-1.0 / 39916800 + r2 * (1.0 / 6227020800.0)))))));
                const double cs = 1.0 + r2 * (-0.5 + r2 * (1.0 / 24 + r2 * (-1.0 / 720 + r2 * (1.0 / 40320 + r2 * (-1.0 / 3628800 + r2 * (1.0 / 479001600.0 + r2 * (-1.0 / 87178291200.0)))))));
                const int q = ((int)nn) & 3;
                const double sv = (q == 0) ? sn : (q == 1) ? cs : (q == 2) ? -sn : -cs;
                const double cv = (q == 0) ? cs : (q == 1) ? -sn : (q == 2) ? -cs : sn;
                cosT[i] = (float)cv; sinT[i] = (float)sv;
            }
        }
        }
    }
    if (P.use_cg) grid.sync();
    GSYNC();

    const int f0 = (G == 256) ? 64 : 0;
    {
        int tid = threadIdx.x; asm volatile("" : "+v"(tid)); const int lane = tid & 63, wid = __builtin_amdgcn_readfirstlane(tid >> 6);
        sw_sets(ws, MOD, SWIN, SWGU, 0, 1, vcu * 8 + wid, G * 8, lds, tid, lane);
    }

    for (int l = 0; l < 2; ++l) {
        unsigned char* wt = ws + (size_t)l * WT_LAYER;
        const float* modl = MOD + (size_t)l * 17 * NMOD;
        const float* xlat = (l == 0) ? P.x : P.out;
        const float* xctx = (l == 0) ? P.ctx : CTXS;
        const int nctx_tiles = (l == 0) ? 16 : 0;
        if (l == 0) { int tid = threadIdx.x; asm volatile("" : "+v"(tid)); const int lane = tid & 63, wid = __builtin_amdgcn_readfirstlane(tid >> 6); (void)lane; (void)wid;
        for (int row = vcu * 8 + wid; row < M_ALL; row += G * 8) {
            const bool isctx = row >= M_LAT;
            const float* xr = isctx ? xctx + (size_t)(row - M_LAT) * D : xlat + (size_t)row * D;
            const float* mr = modl + (size_t)(isctx ? 16 : (row >> 11)) * NMOD;
            norm_mod_row(xr, P.norm1_g + l * D, mr, mr + 1024, XN + (size_t)row * D, lane);
        } }
        if (l == 0) GSYNC();
        for (int half = 0; half < 2; ++half) {
            {
                pg8::Gemm g{XN, (const bf16_t*)(wt + OFF_WIN), D};
                pg8::Order S; S.init(64, 8, 64 * half, 128 + 8 * half, D_IN, G, bx, l == 1);
                EpiIn E{AQ, BQ, AK, AV, BK, BV, CB, PB, GT, cosT, sinT, P.q_norm_g + l * 64, P.k_norm_g + l * 64, (l == 1) ? RSS + M_ALL : nullptr, SWIN, QKMAX + l * 256};
                for (int rep = 0; rep < P1_REP; ++rep) if (PHASE_ON(1)) pg8::gemm_phase<EpiIn>(lds, g, S, E);
            }
            GSYNC();
            {
                int tid = threadIdx.x; asm volatile("" : "+v"(tid)); const int lane = tid & 63, wid = __builtin_amdgcn_readfirstlane(tid >> 6); (void)lane; (void)wid;
                const float* cw = P.conv_w + l * 1536;
                for (int idx = bx * 512 + tid; idx < ((l == 0) ? HROWS : 16384) * 64; idx += G * 512) {
                    const int rr_ = idx >> 6, c8 = (idx & 63) * 8, rowl = (rr_ < 16384) ? rr_ : rr_ + half * 2048;
                    bool hp, hn;
                    if (rowl < 16384) { const int t = rowl & 2047; hp = t > 0; hn = t < 2047; } else { const int j = (rowl - 16384) & 255; hp = j > 0; hn = j < 255; }
                    const u32x4 z4 = {0u, 0u, 0u, 0u};
                    const u32x4 pc = *(const u32x4*)(PB + (size_t)rowl * 512 + c8);
                    const u32x4 pp = hp ? *(const u32x4*)(PB + (size_t)(rowl - 1) * 512 + c8) : z4;
                    const u32x4 pn = hn ? *(const u32x4*)(PB + (size_t)(rowl + 1) * 512 + c8) : z4;
                    const u32x4 cb = *(const u32x4*)(CB + (size_t)rowl * 512 + c8);
                    u32x4 o;
#pragma unroll
                    for (int q = 0; q < 4; ++q) {
                        const int ch = c8 + 2 * q;
                        const float y0 = bflo(cb[q]) * (cw[ch] * bflo(pp[q]) + cw[512 + ch] * bflo(pc[q]) + cw[1024 + ch] * bflo(pn[q]));
                        const float y1 = bfhi(cb[q]) * (cw[ch + 1] * bfhi(pp[q]) + cw[512 + ch + 1] * bfhi(pc[q]) + cw[1024 + ch + 1] * bfhi(pn[q]));
                        o[q] = pk2(y0, y1);
                    }
                    *(u32x4*)(Y + (size_t)rowl * 1536 + 1024 + c8) = o;
                }
                const float lam_init = (l == 0) ? 0.2f : 0.35550906f;
                const float d1 = wave_sum(P.lam_q1[l * 64 + lane] * P.lam_k1[l * 64 + lane], lane), d2 = wave_sum(P.lam_q2[l * 64 + lane] * P.lam_k2[l * 64 + lane], lane);
                const float lam = expf(d1) - expf(d2) + lam_init, oml = 1.0f - lam_init;
                float mq = fabsf(P.q_norm_g[l * 64 + lane]), mk = fabsf(P.k_norm_g[l * 64 + lane]);
#pragma unroll
                for (int o_ = 1; o_ < 64; o_ <<= 1) { mq = fmaxf(mq, sx(mq, o_, lane)); mk = fmaxf(mk, sx(mk, o_, lane)); }
                const bool nomax = __builtin_amdgcn_readfirstlane((64.0f * mq * mk * QSCALE < 20.0f) ? 1 : 0) != 0;
                const int r32 = lane & 31, hi = lane >> 5;
                const int ndiff = (l == 0) ? 256 + 32 : 256, ngqa = (l == 0) ? 512 + 64 : 512;
                for (int rep = 0; rep < ATT_REP; ++rep) {
                if (PHASE_ON(2)) for (int un = vcu; un < ndiff; un += G) {
                    int bl, head, qpos0, nt, rowl0;
                    if (un < 256) { bl = un >> 5; head = (un >> 3) & 3; const int qb = un & 7; qpos0 = 256 + qb * 256; nt = NT_LAT; rowl0 = bl * 2048 + qb * 256; }
                    else { const int w = un - 256; bl = w >> 2; head = w & 3; qpos0 = 0; nt = NT_CTX; rowl0 = 16384 + half * 2048 + bl * 256; }
                    f32x16 o[4];
                    const char* Vt = (const char*)(AV + (size_t)(bl * 4 + head) * NT_LAT * 8192);
                    float* scr = SCR + (size_t)bx * 512 * 64 + tid * 4;
                    for (int hf = 0; hf < 2; ++hf) {
                        const int qi_ = (half * 8 + bl) * 8 + head * 2 + hf;
                        const float qmax2 = __uint_as_float(QKMAX[l * 256 + qi_]), kmax2 = __uint_as_float(QKMAX[l * 256 + 128 + qi_]);
                        const bool fixedref = __builtin_amdgcn_readfirstlane((sqrtf(qmax2 * kmax2) < 60.0f) ? 1 : 0) != 0;
                        if (fixedref) attn_pass_simple<4, true>(AQ + ((size_t)(bl * 8 + head * 2 + hf) * LK + qpos0 + wid * 32) * 64, (const char*)(AK + (size_t)(bl * 8 + head * 2 + hf) * NT_LAT * 4096), Vt, nt, lds, o, kmax2);
                        else attn_pass_simple<4, false>(AQ + ((size_t)(bl * 8 + head * 2 + hf) * LK + qpos0 + wid * 32) * 64, (const char*)(AK + (size_t)(bl * 8 + head * 2 + hf) * NT_LAT * 4096), Vt, nt, lds, o, kmax2);
                        if (hf == 0) {
#pragma unroll
                            for (int d0 = 0; d0 < 4; ++d0)
#pragma unroll
                                for (int r4 = 0; r4 < 4; ++r4) *(f32x4*)(scr + (d0 * 4 + r4) * 2048) = (f32x4){o[d0][4 * r4], o[d0][4 * r4 + 1], o[d0][4 * r4 + 2], o[d0][4 * r4 + 3]};
                        }
                    }
                    asm volatile("" : "+v"(scr));
#pragma unroll
                    for (int d0 = 0; d0 < 4; ++d0)
#pragma unroll
                        for (int r4 = 0; r4 < 4; ++r4) { const f32x4 a = *(const f32x4*)(scr + (d0 * 4 + r4) * 2048);
#pragma unroll
                            for (int j = 0; j < 4; ++j) o[d0][4 * r4 + j] = a[j] - lam * o[d0][4 * r4 + j]; }
                    float gsub[4];
#pragma unroll
                    for (int d0 = 0; d0 < 4; ++d0) gsub[d0] = P.subln_g[l * 128 + 32 * d0 + r32] * oml;
                    LAS bf16_t* stg = (LAS bf16_t*)(lds + A_STG + wid * 8192);
#pragma unroll
                    for (int r = 0; r < 16; ++r) {
                        float ss = 0.f;
#pragma unroll
                        for (int d0 = 0; d0 < 4; ++d0) ss += o[d0][r] * o[d0][r];
                        ss += sx(ss, 1, lane); ss += sx(ss, 2, lane); ss += sx(ss, 4, lane); ss += sx(ss, 8, lane); ss += sx(ss, 16, lane);
                        const float rinv = rsqrtf(ss * (1.0f / 128.0f) + EPS);
#pragma unroll
                        for (int d0 = 0; d0 < 4; ++d0) stg[crow(r, hi) * 128 + 32 * d0 + r32] = f2bf(o[d0][r] * rinv * gsub[d0]);
                    }
                    asm volatile("s_waitcnt lgkmcnt(0)" ::: "memory");
                    bf16_t* yb = Y + (size_t)(rowl0 + wid * 32 + (lane >> 4)) * 1536 + head * 128 + (lane & 15) * 8;
                    asm volatile("" : "+v"(yb));
#pragma unroll
                    for (int it = 0; it < 8; ++it) { const u32x4 v = *(const LAS u32x4*)(stg + (it * 4 + (lane >> 4)) * 128 + (lane & 15) * 8); *(u32x4*)(yb + (size_t)it * 4 * 1536) = v; }
                    asm volatile("s_waitcnt lgkmcnt(0)" ::: "memory");
                }
                if (PHASE_ON(3)) for (int un = vcu; un < ngqa; un += G) {
                    int bl, qh, qpos0, nt, rowl0;
                    if (un < 512) { bl = un >> 6; qh = (un >> 3) & 7; const int qb = un & 7; qpos0 = 256 + qb * 256; nt = NT_LAT; rowl0 = bl * 2048 + qb * 256; }
                    else { const int w = un - 512; bl = w >> 3; qh = w & 7; qpos0 = 0; nt = NT_CTX; rowl0 = 16384 + half * 2048 + bl * 256; }
                    f32x16 o[2];
                    const int kvh = qh >> 2;
                    if (nomax) attn_pass<2, true>(BQ + ((size_t)(bl * 8 + qh) * LK + qpos0 + wid * 32) * 64, (const char*)(BK + (size_t)(bl * 2 + kvh) * NT_LAT * 4096), (const char*)(BV + (size_t)(bl * 2 + kvh) * NT_LAT * 4096), nt, lds, o);
                    else attn_pass<2, false>(BQ + ((size_t)(bl * 8 + qh) * LK + qpos0 + wid * 32) * 64, (const char*)(BK + (size_t)(bl * 2 + kvh) * NT_LAT * 4096), (const char*)(BV + (size_t)(bl * 2 + kvh) * NT_LAT * 4096), nt, lds, o);
                    LAS bf16_t* stg = (LAS bf16_t*)(lds + A_STG + wid * 8192);
#pragma unroll
                    for (int r = 0; r < 16; ++r)
#pragma unroll
                        for (int d0 = 0; d0 < 2; ++d0) stg[crow(r, hi) * 64 + 32 * d0 + r32] = f2bf(o[d0][r]);
                    asm volatile("s_waitcnt lgkmcnt(0)" ::: "memory");
                    bf16_t* yb = Y + (size_t)(rowl0 + wid * 32 + (lane >> 3)) * 1536 + 512 + qh * 64 + (lane & 7) * 8;
                    asm volatile("" : "+v"(yb));
#pragma unroll
                    for (int it = 0; it < 4; ++it) { const u32x4 v = *(const LAS u32x4*)(stg + (it * 8 + (lane >> 3)) * 64 + (lane & 7) * 8); *(u32x4*)(yb + (size_t)it * 8 * 1536) = v; }
                    asm volatile("s_waitcnt lgkmcnt(0)" ::: "memory");
                }
                }
            }
            GSYNC();
            {
                pg8::Gemm g{Y, (const bf16_t*)(wt + OFF_WBR), 1536};
                pg8::Order S; S.init(64, (l == 0 && half == 1) ? 16 : 0, 0, 64, D, G, bx);
                EpiMerge E{GT, XN, half};
                if (PHASE_ON(4)) pg8::gemm_phase<EpiMerge>(lds, g, S, E);
                if (l == 0 && half == 1 && bx >= f0) {
                    int tid = threadIdx.x; asm volatile("" : "+v"(tid)); const int lane = tid & 63, wid = __builtin_amdgcn_readfirstlane(tid >> 6);
                    transpose_layer(P, ws, 1, (bx - f0) * 8 + wid, (G - f0) * 8, (LAS float*)(lds + wid * 16384), lane);
                }
            }
            GSYNC();
        }
        {
            pg8::Gemm g{XN, (const bf16_t*)(wt + OFF_WOUT), D};
            pg8::Order S; S.init(128, nctx_tiles, 0, 128, D, G, bx);
            EpiRes E{xlat, P.out, xctx, CTXS, modl + 2 * 1024, XN2, P.norm2_g + l * D, modl + 4 * 1024, RSS + (l == 0 ? 0 : 2 * M_ALL)};
            if (PHASE_ON(5)) pg8::gemm_phase<EpiRes>(lds, g, S, E);
            if (l == 0 && bx >= f0) {
                int tid = threadIdx.x; asm volatile("" : "+v"(tid)); const int lane = tid & 63, wid = __builtin_amdgcn_readfirstlane(tid >> 6);
                sw_sets(ws, MOD, SWIN, SWGU, 1, 3, (bx - f0) * 8 + wid, (G - f0) * 8, lds, tid, lane);
            }
        }
        GSYNC();
        {
            const bool split5 = (l == 0 && G == 256);
            pg8::Gemm g5{XN2, (const bf16_t*)(wt + OFF_WGU), D};
            pg8::Gemm g6{HB, (const bf16_t*)(wt + OFF_WDN), D_FF};
            EpiGlu E5{HB, RSS + (l == 0 ? 0 : 2 * M_ALL), SWGU + (size_t)l * 17 * (2 * D_FF)};
            for (int part = 0; part < (split5 ? 2 : 1); ++part) {
                pg8::Order S;
                if (!split5) S.init(128, nctx_tiles, 0, 128, 2 * D_FF, G, bx);
                else if (part == 0) { S.init(128, 16, 0, 128, 2 * D_FF, G, bx); S.mode = 1; S.nwg = 512; }
                else { S.init(128, 0, 0, 128, 2 * D_FF, G, bx); S.mode = 2; S.offs = 160; }
                if (PHASE_ON(6)) pg8::gemm_phase<EpiGlu>(lds, g5, S, E5);
                if (split5 && part == 1 && bx >= 192) {
                    pg8::Order S6; S6.init(128, 0, 0, 128, D, G, bx); S6.mode = 3; S6.spm = 128 + (bx - 192) % 16; S6.spn = (bx - 192) / 16;
                    EpiRes E6{P.out, P.out, CTXS, CTXS, modl + 5 * 1024, XN, P.norm1_g + D, MOD + (size_t)17 * NMOD + 1024, RSS + M_ALL};
                    pg8::gemm_phase<EpiRes>(lds, g6, S6, E6);
                }
                GSYNC();
            }
            {
                pg8::Order S; S.init(128, split5 ? 0 : nctx_tiles, 0, 128, D, G, bx);
                EpiRes E6{P.out, P.out, CTXS, CTXS, modl + 5 * 1024, (l == 0) ? XN : nullptr, P.norm1_g + D, MOD + (size_t)17 * NMOD + 1024, RSS + M_ALL};
                if (PHASE_ON(7)) pg8::gemm_phase<EpiRes>(lds, g6, S, E6);
            }
        }
        GSYNC();
    }
    int tid = threadIdx.x; asm volatile("" : "+v"(tid)); const int lane = tid & 63, wid = __builtin_amdgcn_readfirstlane(tid >> 6); (void)lane; (void)wid;
    for (int row = vcu * 8 + wid; row < M_LAT; row += G * 8) {
        float* xr = P.out + (size_t)row * D;
        f32x4 v[4]; float s = 0.f;
#pragma unroll
        for (int j = 0; j < 4; ++j) { v[j] = *(const f32x4*)(xr + 4 * lane + 256 * j); s += (v[j][0] * v[j][0] + v[j][1] * v[j][1]) + (v[j][2] * v[j][2] + v[j][3] * v[j][3]); }
        const float rinv = rsqrtf(wave_sum(s, lane) * (1.0f / D) + EPS);
#pragma unroll
        for (int j = 0; j < 4; ++j) *(f32x4*)(xr + 4 * lane + 256 * j) = v[j] * rinv * *(const f32x4*)(P.final_g + 4 * lane + 256 * j);
    }
}

extern "C" void kernel_launch(void* const* d_in, const int* in_sizes, int n_in, void* d_out, int out_size, void* d_ws, size_t ws_size, hipStream_t stream) {
    static int grid = 0;
    if (grid == 0) {
        if (n_in != 24 || out_size != M_LAT * D || ws_size < WS_END) { fprintf(stderr, "kernel_launch: unexpected shapes (n_in %d out %d ws %zu); nothing launched\n", n_in, out_size, ws_size); grid = -1; return; }
        int dev = 0, cus = 0, per_cu = 0;
        if (hipGetDevice(&dev) != hipSuccess || hipDeviceGetAttribute(&cus, hipDeviceAttributeMultiprocessorCount, dev) != hipSuccess) { grid = -1; return; }
        if (hipFuncSetAttribute((const void*)fwd_kernel, hipFuncAttributeMaxDynamicSharedMemorySize, LDS_BYTES) != hipSuccess) { fprintf(stderr, "kernel_launch: hipFuncSetAttribute failed\n"); grid = -1; return; }
        if (hipOccupancyMaxActiveBlocksPerMultiprocessor(&per_cu, (const void*)fwd_kernel, 512, LDS_BYTES) != hipSuccess || per_cu < 1) per_cu = 1;
        (void)hipGetLastError();
        grid = cus < 256 ? cus : 256;
    }
    if (grid < 0) return;
    if (hipMemsetAsync((char*)d_ws + WS_BAR, 0, XCD_BAR_WORDS * 4, stream) != hipSuccess) { fprintf(stderr, "kernel_launch: memset of the barrier words failed\n"); return; }
    Params p{};
    const float** pp = (const float**)&p;
    for (int i = 0; i < 24; ++i) pp[i] = (const float*)d_in[i];
    p.out = (float*)d_out; p.ws = (unsigned char*)d_ws;
    void* args[] = {&p};
    hipError_t e = hipLaunchCooperativeKernel((void*)fwd_kernel, dim3(grid), dim3(512), args, LDS_BYTES, stream);
    if (e != hipSuccess) fprintf(stderr, "cooperative launch failed: %s (grid %d)\n", hipGetErrorString(e), grid);
}
```

```cpp
#include <hip/hip_runtime.h>
#include <hip/hip_cooperative_groups.h>
#include <cstdio>
#include <cstdint>
namespace cg = cooperative_groups;

#define LAS __attribute__((address_space(3)))
typedef unsigned short bf16_t;
typedef short bf16x8 __attribute__((ext_vector_type(8)));
typedef float f32x2 __attribute__((ext_vector_type(2)));
typedef float f32x4 __attribute__((ext_vector_type(4)));
typedef float f32x16 __attribute__((ext_vector_type(16)));
typedef unsigned u32x2 __attribute__((ext_vector_type(2)));
typedef unsigned u32x4 __attribute__((ext_vector_type(4)));
typedef __bf16 bf16x2_t __attribute__((ext_vector_type(2)));

__device__ __forceinline__ unsigned pk2(float lo, float hi) { f32x2 v = {lo, hi}; bf16x2_t b = __builtin_convertvector(v, bf16x2_t); return __builtin_bit_cast(unsigned, b); }
__device__ __forceinline__ float bflo(unsigned w) { return __uint_as_float(w << 16); }
__device__ __forceinline__ float bfhi(unsigned w) { return __uint_as_float(w & 0xffff0000u); }
__device__ __forceinline__ void st4(bf16_t* p, f32x4 v) { u32x2 w; w.x = pk2(v[0], v[1]); w.y = pk2(v[2], v[3]); *(u32x2*)p = w; }
__device__ __forceinline__ void st8(bf16_t* p, f32x4 a, f32x4 b) { u32x4 w; w.x = pk2(a[0], a[1]); w.y = pk2(a[2], a[3]); w.z = pk2(b[0], b[1]); w.w = pk2(b[2], b[3]); *(u32x4*)p = w; }
__host__ __device__ __forceinline__ int ip32(int x) { return 16 * ((x >> 2) & 1) + 4 * (x >> 3) + (x & 3); }
__device__ __forceinline__ f32x4 ld4(const bf16_t* p) { const u32x2 w = *(const u32x2*)p; return (f32x4){bflo(w.x), bfhi(w.x), bflo(w.y), bfhi(w.y)}; }
__device__ __forceinline__ bf16_t f2bf(float f) { return (bf16_t)(pk2(f, 0.f) & 0xffffu); }
__device__ __forceinline__ float sx(float v, int m, int lane) { return __int_as_float(__builtin_amdgcn_ds_bpermute((lane ^ m) << 2, __float_as_int(v))); }
__device__ __forceinline__ float sigmoidf_(float z) { return __builtin_amdgcn_rcpf(1.0f + __expf(-z)); }

constexpr int D = 1024, SEQ = 2048, CTXL = 256, LK = 2304, NT_LAT = 36, NT_CTX = 4;
constexpr int M_LAT = 32768, M_CTX = 4096, M_ALL = 36864;
constexpr int D_IN = 6912, D_FF = 2816, NMOD = 6144, HROWS = 18432;
constexpr float EPS = 1e-6f;
constexpr float QSCALE = 0.125f * 1.4426950408889634f;

constexpr size_t MiB = 1u << 20;
constexpr size_t WT_LAYER = 36700160;
constexpr size_t OFF_WIN = 0, OFF_WBR = 14155776, OFF_WOUT = 17301504, OFF_WGU = 19398656, OFF_WDN = 30932992;
constexpr size_t WS_MOD = 70 * MiB, WS_ROPE = 70 * MiB + 896 * 1024, WS_BAR = 70 * MiB + 960 * 1024;
constexpr size_t WS_CTXS = 71 * MiB, WS_XN = 87 * MiB, WS_BIG = 159 * MiB;
constexpr size_t B_AQ = WS_BIG, B_BQ = WS_BIG + 18 * MiB, B_AK = WS_BIG + 36 * MiB, B_AV = WS_BIG + 54 * MiB, B_BK = WS_BIG + 72 * MiB, B_BV = WS_BIG + 76 * MiB + 512 * 1024;
constexpr size_t B_CB = WS_BIG + 81 * MiB, B_PB = WS_BIG + 101 * MiB, B_G = WS_BIG + 121 * MiB, B_Y = WS_BIG + 241 * MiB, B_SCR = WS_BIG + 301 * MiB;
constexpr size_t B_XN2 = WS_BIG, B_H = WS_BIG + 72 * MiB;
constexpr size_t WS_SWGU = WS_BIG + 333 * MiB, WS_SWIN = WS_SWGU + 1 * MiB, WS_RSS = WS_SWIN + 1 * MiB;
constexpr size_t WS_END = WS_RSS + 1 * MiB;

namespace pg8 {
constexpr int BM = 256, BK = 64, HALF = 128, HTB = HALF * BK * 2, STAGE_BYTES = 8 * HTB, NXCD = 8, WGM = 4;
__host__ __device__ __forceinline__ int lds_byte(int r, int c) { const int st = (r >> 4) * 2 + (c >> 5), rr = r & 15, cc = c & 31, ob = rr * 64 + cc * 2; return st * 1024 + (ob ^ (((ob >> 9) & 1) << 5)); }
__host__ __device__ __forceinline__ void stage_rc(int b, int& R, int& C) { const int st = b / 1024, sb = b % 1024, swz = sb ^ (((sb >> 9) & 1) << 5); R = (st >> 1) * 16 + swz / 64; C = (st & 1) * 32 + (swz % 64) / 2; }

struct Unit { int pm, pn; };
struct Gemm { const bf16_t* A; const bf16_t* Bt; int K; };

struct Order {
    int nM, nN, nmain, nwg, G, c, nctx, lat0, ctx0, kvonly;
    int mode, offs, spm, spn;
    __device__ void init(int nlat_, int nctx_, int lat0_, int ctx0_, int N, int G_, int c_, int kvonly_ = 0) {
        nM = nlat_; nctx = nctx_; lat0 = lat0_; ctx0 = ctx0_; nN = N / BM; nmain = nM * nN; kvonly = kvonly_; nwg = nmain + nctx_ * (kvonly_ ? 5 : nN); G = G_; c = c_; mode = 0; offs = 0; spm = 0; spn = 0; }
    __device__ void main_unit(int m, Unit& u) const {
        const int q = nmain / NXCD, r = nmain % NXCD, xcd = m % NXCD, off = m / NXCD;
        const int wgid = (xcd < r ? xcd * (q + 1) : r * (q + 1) + (xcd - r) * q) + off;
        const int nig = WGM * nN, gid = wgid / nig, fm = gid * WGM, gsz = (nM - fm) < WGM ? (nM - fm) : WGM;
        u.pm = lat0 + fm + ((wgid % nig) % gsz); u.pn = (wgid % nig) / gsz;
    }
    __device__ bool next(int i, Unit& u) const {
        if (mode == 1) {
            const int L = i * G + c, nc = nctx * nN; if (L >= nwg) return false;
            if (L < nc) { u.pm = ctx0 + L % nctx; u.pn = L / nctx; } else main_unit(L - nc, u);
            return true;
        }
        if (mode == 2) {
            int L;
            if (i < 8) L = i * 256 + c; else if (c < 192 && i < 11) L = 2048 + (i - 8) * 192 + c; else if (c >= 192 && c < 224 && i == 8) L = 2624 + (c - 192); else return false;
            main_unit(offs + L, u); return true;
        }
        if (mode == 3) { if (i == 0 && c >= 192) { u.pm = spm; u.pn = spn; return true; } return false; }
        const long L = (long)i * G + c; if (L >= nwg) return false;
        int wgid = (int)L; { const int q = nwg / NXCD, r = nwg % NXCD, xcd = wgid % NXCD, off = wgid / NXCD; wgid = (xcd < r ? xcd * (q + 1) : r * (q + 1) + (xcd - r) * q) + off; }
        if (wgid < nmain) {
            const int nig = WGM * nN, gid = wgid / nig, fm = gid * WGM, gsz = (nM - fm) < WGM ? (nM - fm) : WGM;
            u.pm = lat0 + fm + ((wgid % nig) % gsz); u.pn = (wgid % nig) / gsz;
        } else {
            const int j = wgid - nmain, k = j / nctx;
            u.pm = ctx0 + j % nctx; u.pn = kvonly ? (int)((0x85432u >> (4 * k)) & 15u) : k;
        }
        return true;
    }
};

template <class Epi>
__device__ __forceinline__ void gemm_phase(LAS unsigned char* lds, const Gemm g, const Order& S, const Epi& E) {
    int tid = threadIdx.x; asm volatile("" : "+v"(tid));
    const int wid = __builtin_amdgcn_readfirstlane(tid >> 6), lane = tid & 63, wr = wid >> 2, wc = wid & 3, fr = lane & 15, fq = lane >> 4;
    const int K = g.K, nt = K / BK;
    unsigned voffA[2];
#pragma unroll
    for (int i = 0; i < 2; ++i) { int R, C; stage_rc(tid * 16 + i * 8192, R, C); voffA[i] = (unsigned)(R * K + C) * 2u; }
    const size_t kstep = (size_t)(BK * 2);
    const size_t hstep = (size_t)HALF * K * 2;
    const size_t tstep = 2 * hstep;
    const unsigned ldsw = (unsigned)wid * 1024u;
    const int aoff = lds_byte(wr * 64 + fr, fq * 8), boff = lds_byte(wc * 32 + fr, fq * 8);
#define PG8_SA(b, h) (((b) * 2 + (h)) * HTB)
#define PG8_SB(b, h) ((4 + (b) * 2 + (h)) * HTB)
#define PG8_STAGE(bufoff, gbase, voff) do { _Pragma("unroll") for (int _i = 0; _i < 2; ++_i) \
        __builtin_amdgcn_global_load_lds((const unsigned*)((const char*)(gbase) + (voff)[_i]), (LAS unsigned*)(lds + (bufoff) + ldsw + _i * 8192), 16, 0, 0); } while (0)
#define PG8_LDA(dst, b, h) do { _Pragma("unroll") for (int m = 0; m < 4; ++m) _Pragma("unroll") for (int k = 0; k < 2; ++k) dst[m][k] = *(const LAS bf16x8*)(lds + PG8_SA(b, h) + aoff + m * 2048 + k * 1024); } while (0)
#define PG8_LDB(dst, b, h) do { _Pragma("unroll") for (int n = 0; n < 2; ++n) _Pragma("unroll") for (int k = 0; k < 2; ++k) dst[n][k] = *(const LAS bf16x8*)(lds + PG8_SB(b, h) + boff + n * 2048 + k * 1024); } while (0)
#define PG8_MMA(ai, bj, At, Bt) do { __builtin_amdgcn_s_setprio(1); _Pragma("unroll") for (int m = 0; m < 4; ++m) _Pragma("unroll") for (int n = 0; n < 2; ++n) _Pragma("unroll") for (int k = 0; k < 2; ++k) \
        acc[ai][bj][m][n] = __builtin_amdgcn_mfma_f32_16x16x32_bf16(Bt[n][k], At[m][k], acc[ai][bj][m][n], 0, 0, 0); __builtin_amdgcn_s_setprio(0); } while (0)
#define PG8_WAIT_V(n) asm volatile("s_waitcnt vmcnt(" #n ")" ::: "memory")
#define PG8_WAIT_L(n) asm volatile("s_waitcnt lgkmcnt(" #n ")" ::: "memory")
#define PG8_BAR __builtin_amdgcn_s_barrier()
#define PG8_SCHED __builtin_amdgcn_sched_barrier(0)
    Unit cur, nxt; int ui = 0;
    if (!S.next(0, cur)) return;
    f32x4 acc[2][2][4][2];
#pragma unroll
    for (int a = 0; a < 2; ++a)
#pragma unroll
        for (int b = 0; b < 2; ++b)
#pragma unroll
            for (int m = 0; m < 4; ++m)
#pragma unroll
                for (int n = 0; n < 2; ++n) acc[a][b][m][n] = (f32x4){0.f, 0.f, 0.f, 0.f};
    bf16x8 At[4][2], B0[2][2], B1[2][2];
    const char* cA = (const char*)g.A + (size_t)cur.pm * tstep; const char* cB = (const char*)g.Bt + (size_t)cur.pn * tstep;
    PG8_STAGE(PG8_SB(0, 0), cB, voffA); PG8_STAGE(PG8_SB(0, 1), cB + hstep, voffA); PG8_STAGE(PG8_SA(0, 0), cA, voffA); PG8_STAGE(PG8_SA(0, 1), cA + hstep, voffA);
    if (wr == 1) PG8_BAR;
    PG8_WAIT_V(2); PG8_BAR;
    PG8_STAGE(PG8_SB(1, 0), cB + kstep, voffA); PG8_STAGE(PG8_SA(1, 0), cA + kstep, voffA); PG8_STAGE(PG8_SB(1, 1), cB + hstep + kstep, voffA);
    PG8_WAIT_V(6); PG8_BAR;
    for (;;) {
        const bool has_next = S.next(ui + 1, nxt);
        const char* nA = has_next ? (const char*)g.A + (size_t)nxt.pm * tstep : cA; const char* nB = has_next ? (const char*)g.Bt + (size_t)nxt.pn * tstep : cB;
        for (int t = 0; t < nt; t += 2) {
            if constexpr (Epi::HOOK) { if (t == 8 || t == 16) E.hook(acc, cur, t, wr, wc, fr, fq); }
            const bool last = (t == nt - 2);
            const char* a1 = cA + (size_t)(t + 1) * kstep;
            const char* a2 = last ? nA : cA + (size_t)(t + 2) * kstep; const char* b2 = last ? nB : cB + (size_t)(t + 2) * kstep;
            const char* a3 = a2 + kstep; const char* b3 = b2 + kstep;
            PG8_LDB(B0, 0, 0); PG8_LDB(B1, 0, 1); PG8_SCHED; PG8_LDA(At, 0, 0); PG8_STAGE(PG8_SA(1, 1), a1 + hstep, voffA);
            PG8_WAIT_V(8); PG8_WAIT_L(0); PG8_BAR; PG8_MMA(0, 0, At, B0); PG8_MMA(0, 1, At, B1); PG8_BAR; PG8_SCHED;
            PG8_LDA(At, 0, 1); PG8_STAGE(PG8_SB(0, 0), b2, voffA); PG8_STAGE(PG8_SB(0, 1), b2 + hstep, voffA); PG8_STAGE(PG8_SA(0, 0), a2, voffA);
            PG8_WAIT_V(8); PG8_WAIT_L(0); PG8_BAR; PG8_MMA(1, 0, At, B0); PG8_MMA(1, 1, At, B1); PG8_BAR; PG8_SCHED;
            PG8_LDB(B0, 1, 0); PG8_LDB(B1, 1, 1); PG8_SCHED; PG8_LDA(At, 1, 0); PG8_STAGE(PG8_SA(0, 1), a2 + hstep, voffA);
            PG8_WAIT_V(8); PG8_WAIT_L(0); PG8_BAR; PG8_MMA(0, 0, At, B0); PG8_MMA(0, 1, At, B1); PG8_BAR; PG8_SCHED;
            PG8_LDA(At, 1, 1); PG8_STAGE(PG8_SB(1, 0), b3, voffA); PG8_STAGE(PG8_SB(1, 1), b3 + hstep, voffA); PG8_STAGE(PG8_SA(1, 0), a3, voffA);
            PG8_WAIT_V(8); PG8_WAIT_L(0); PG8_BAR; PG8_MMA(1, 0, At, B0); PG8_MMA(1, 1, At, B1); PG8_BAR; PG8_SCHED;
        }
        if (wr == 0) PG8_BAR;
        E(acc, cur, wr, wc, fr, fq);
        if (!has_next) break;
#pragma unroll
        for (int a = 0; a < 2; ++a)
#pragma unroll
            for (int b = 0; b < 2; ++b)
#pragma unroll
                for (int m = 0; m < 4; ++m)
#pragma unroll
                    for (int n = 0; n < 2; ++n) acc[a][b][m][n] = (f32x4){0.f, 0.f, 0.f, 0.f};
        cur = nxt; cA = nA; cB = nB; ++ui;
        if (wr == 1) PG8_BAR;
    }
    PG8_WAIT_V(0);
    PG8_BAR;
#undef PG8_SA
#undef PG8_SB
#undef PG8_STAGE
#undef PG8_LDA
#undef PG8_LDB
#undef PG8_MMA
#undef PG8_WAIT_V
#undef PG8_WAIT_L
#undef PG8_BAR
#undef PG8_SCHED
}
}
using pg8::Unit;
typedef f32x4 Acc[2][2][4][2];

__device__ __forceinline__ f32x4 quad_transpose(f32x4 x, int ln) {
    const bool b0 = ln & 1, b1 = ln & 2;
    { const float r0 = sx(b0 ? x[0] : x[1], 1, ln), r1 = sx(b0 ? x[2] : x[3], 1, ln); if (b0) { x[0] = r0; x[2] = r1; } else { x[1] = r0; x[3] = r1; } }
    { const float r0 = sx(b1 ? x[0] : x[2], 2, ln), r1 = sx(b1 ? x[1] : x[3], 2, ln); if (b1) { x[0] = r0; x[1] = r1; } else { x[2] = r0; x[3] = r1; } }
    return x;
}
__device__ __forceinline__ int pi16(int k) { return ((k & 4) << 1) | ((k & 8) >> 1) | (k & 3); }

struct EpiIn {
    static constexpr bool HOOK = false;
    bf16_t *AQ, *BQ, *AK, *AV, *BK, *BV, *CB, *PB, *G;
    const float *cosT, *sinT, *qg, *kg;
    const float *rss, *sw;
    unsigned* qkmax;
    __device__ __forceinline__ void operator()(const Acc& acc, const Unit& u, int wr, int wc, int fr, int fq) const {
        asm volatile("" : "+v"(fr), "+v"(fq));
        const int pm = u.pm, pn = u.pn;
        const bool isctx = pm >= 128;
        int bl, posb, rowlb, tb;
        if (!isctx) { bl = (pm >> 3) & 7; tb = (pm & 7) * 256; posb = 256 + tb; rowlb = bl * 2048 + tb; }
        else { bl = (pm - 128) & 7; tb = 0; posb = 0; rowlb = 16384 + (pm - 128) * 256; }
        const int rbase = 64 * wr + fr;
        float rv[8]; f32x4 sw4[2][2];
#pragma unroll
        for (int g = 0; g < 8; ++g) rv[g] = 1.0f;
#pragma unroll
        for (int bj = 0; bj < 2; ++bj)
#pragma unroll
            for (int n = 0; n < 2; ++n) sw4[bj][n] = (f32x4){0.f, 0.f, 0.f, 0.f};
        if (rss) {
#pragma unroll
            for (int g = 0; g < 8; ++g) rv[g] = rsqrtf(rss[pm * 256 + 128 * (g >> 2) + 16 * (g & 3) + rbase] * (1.0f / D) + EPS);
            const float* swp = sw + (size_t)(isctx ? 16 : (pm >> 3)) * D_IN + pn * 256 + 32 * wc + 4 * fq;
#pragma unroll
            for (int bj = 0; bj < 2; ++bj)
#pragma unroll
                for (int n = 0; n < 2; ++n) sw4[bj][n] = *(const f32x4*)(swp + 128 * bj + 16 * n);
        }
#define AV_(ai, bj, m, n) (acc[ai][bj][m][n] * rv[(ai) * 4 + (m)] + sw4[bj][n])
        if (pn < 4 || (pn >= 6 && pn <= 8)) {
            const bool isq = (pn < 2) || (pn == 6) || (pn == 7);
            const bool isqk = pn < 4; float nmx = 0.f;
            const bool isv = (pn == 8) && (wc >= 2);
            const bool donorm = (pn >= 6) && !isv;
            const bool dorope = !isctx && !isv;
            const float* gn = (pn == 8) ? kg : qg;
            f32x4 g4[2][2];
#pragma unroll
            for (int bj = 0; bj < 2; ++bj)
#pragma unroll
                for (int n = 0; n < 2; ++n) g4[bj][n] = *(const f32x4*)(gn + 32 * bj + 16 * n + 4 * fq);
#pragma unroll
            for (int ai = 0; ai < 2; ++ai)
#pragma unroll
                for (int m = 0; m < 4; ++m) {
                    const int rr = 128 * ai + 16 * m + rbase, pos = posb + rr, t = tb + rr;
                    f32x4 v[2][2];
#pragma unroll
                    for (int bj = 0; bj < 2; ++bj)
#pragma unroll
                        for (int n = 0; n < 2; ++n) v[bj][n] = AV_(ai, bj, m, n);
                    if (donorm) {
                        float ss = 0.f;
#pragma unroll
                        for (int bj = 0; bj < 2; ++bj)
#pragma unroll
                            for (int n = 0; n < 2; ++n) { const f32x4 x = v[bj][n]; ss += (x[0] * x[0] + x[1] * x[1]) + (x[2] * x[2] + x[3] * x[3]); }
                        { const int ln = fq * 16 + fr; ss += sx(ss, 16, ln); ss += sx(ss, 32, ln); }
                        const float rinv = rsqrtf(ss * (1.0f / 64.0f) + EPS);
#pragma unroll
                        for (int bj = 0; bj < 2; ++bj)
#pragma unroll
                            for (int n = 0; n < 2; ++n) v[bj][n] = v[bj][n] * rinv * g4[bj][n];
                    }
                    if (dorope) {
#pragma unroll
                        for (int bj = 0; bj < 2; ++bj) {
                            const int pv = (bj == 0) ? (t >> 6) : (t & 63);
                            const f32x4 c4 = *(const f32x4*)(cosT + pv * 16 + 4 * fq), s4 = *(const f32x4*)(sinT + pv * 16 + 4 * fq);
                            const f32x4 x1 = v[bj][0], x2 = v[bj][1];
                            v[bj][0] = x1 * c4 - x2 * s4; v[bj][1] = x2 * c4 + x1 * s4;
                        }
                    }
                    if (isqk) {
                        const float sc_ = (pn < 2) ? QSCALE : 1.0f; float s2 = 0.f;
#pragma unroll
                        for (int bj = 0; bj < 2; ++bj)
#pragma unroll
                            for (int n = 0; n < 2; ++n) { const f32x4 x = v[bj][n] * sc_; s2 += (x[0] * x[0] + x[1] * x[1]) + (x[2] * x[2] + x[3] * x[3]); }
                        { const int ln = fq * 16 + fr; s2 += sx(s2, 16, ln); s2 += sx(s2, 32, ln); }
                        nmx = fmaxf(nmx, s2);
                    }
                    if (isq) {
                        const int slot = ((pn < 2) ? pn * 4 : (pn - 6) * 4) + wc;
                        bf16_t* base = ((pn < 2) ? AQ : BQ) + ((size_t)(bl * 8 + slot) * LK + pos) * 64 + 4 * fq;
#pragma unroll
                        for (int bj = 0; bj < 2; ++bj)
#pragma unroll
                            for (int n = 0; n < 2; ++n) st4(base + 32 * bj + 16 * n, v[bj][n] * QSCALE);
                    } else if (!isv) {
                        const int slot = (pn == 8) ? wc : (pn - 2) * 4 + wc, NS = (pn == 8) ? 2 : 8;
                        bf16_t* base = ((pn == 8) ? BK : AK) + ((size_t)(bl * NS + slot) * NT_LAT + (pos >> 6)) * 4096 + (pos & 63) * 8;
#pragma unroll
                        for (int bj = 0; bj < 2; ++bj)
#pragma unroll
                            for (int n = 0; n < 2; ++n) { const int d = 32 * bj + 16 * n + 4 * fq; st4(base + (d >> 3) * 512 + (d & 7), v[bj][n]); }
                    } else {
                        const int h = wc - 2, k = pos & 63, kq = (k >> 2) & 3, ln = fq * 16 + fr;
                        bf16_t* base = BV + ((size_t)(bl * 2 + h) * NT_LAT + (pos >> 6)) * 4096 + (2 * (k >> 4) + (kq & 1)) * 512 + 4 * (kq >> 1) + (4 * fq + (fr & 3)) * 8;
#pragma unroll
                        for (int bj = 0; bj < 2; ++bj)
#pragma unroll
                            for (int n = 0; n < 2; ++n) st4(base + (32 * bj + 16 * n) * 8, quad_transpose(v[bj][n], ln));
                    }
                }
            if (isqk) {
                const int ln = fq * 16 + fr;
                nmx = fmaxf(nmx, sx(nmx, 1, ln)); nmx = fmaxf(nmx, sx(nmx, 2, ln)); nmx = fmaxf(nmx, sx(nmx, 4, ln)); nmx = fmaxf(nmx, sx(nmx, 8, ln));
                if (ln == 0) atomicMax(qkmax + ((pn >> 1) * 16 + (isctx ? pm - 128 : (pm >> 3))) * 8 + (pn & 1) * 4 + wc, __float_as_uint(nmx));
            }
        } else if (pn == 4 || pn == 5) {
#pragma unroll
            for (int ai = 0; ai < 2; ++ai)
#pragma unroll
                for (int m = 0; m < 4; ++m) {
                    const int rr = 128 * ai + 16 * m + rbase, pos = posb + rr, k = pos & 63, kq = (k >> 2) & 3, ln = fq * 16 + fr;
#pragma unroll
                    for (int bj = 0; bj < 2; ++bj) {
                        const int head = (pn - 4) * 2 + bj;
                        bf16_t* base = AV + ((size_t)(bl * 4 + head) * NT_LAT + (pos >> 6)) * 8192 + (2 * (k >> 4) + (kq & 1)) * 1024 + 4 * (kq >> 1) + (32 * wc + 4 * fq + (fr & 3)) * 8;
#pragma unroll
                        for (int n = 0; n < 2; ++n) st4(base + 16 * n * 8, quad_transpose(AV_(ai, bj, m, n), ln));
                    }
                }
        } else if (pn <= 10) {
#pragma unroll
            for (int ai = 0; ai < 2; ++ai)
#pragma unroll
                for (int m = 0; m < 4; ++m) {
                    bf16_t* base = CB + (size_t)(rowlb + 128 * ai + 16 * m + rbase) * 512 + (pn - 9) * 256 + 32 * wc + 8 * fq;
#pragma unroll
                    for (int bj = 0; bj < 2; ++bj) st8(base + 128 * bj, AV_(ai, bj, m, 0), AV_(ai, bj, m, 1));
                }
        } else if (pn <= 14) {
#pragma unroll
            for (int ai = 0; ai < 2; ++ai)
#pragma unroll
                for (int m = 0; m < 4; ++m) {
                    bf16_t* base = PB + (size_t)(rowlb + 128 * ai + 16 * m + rbase) * 512 + (pn - 11) * 128 + 32 * wc + 8 * fq;
                    st8(base, AV_(ai, 0, m, 0) * AV_(ai, 1, m, 0), AV_(ai, 0, m, 1) * AV_(ai, 1, m, 1));
                }
        } else {
#pragma unroll
            for (int ai = 0; ai < 2; ++ai)
#pragma unroll
                for (int m = 0; m < 4; ++m) {
                    bf16_t* base = G + ((size_t)((rowlb >> 8) * 12 + (pn - 15)) * 8 + (wr * 4 + wc)) * 8192 + (fq * 16 + fr) * 8 + (ai * 4 + m) * 1024;
#pragma unroll
                    for (int bj = 0; bj < 2; ++bj) { const f32x4 z0 = AV_(ai, bj, m, 0), z1 = AV_(ai, bj, m, 1);
                        st8(base + bj * 512, (f32x4){sigmoidf_(z0[0]), sigmoidf_(z0[1]), sigmoidf_(z0[2]), sigmoidf_(z0[3])}, (f32x4){sigmoidf_(z1[0]), sigmoidf_(z1[1]), sigmoidf_(z1[2]), sigmoidf_(z1[3])}); }
                }
        }
    }
#undef AV_
};

struct EpiMerge {
    static constexpr bool HOOK = true;
    const bf16_t* G; bf16_t* MG; int half;
    __device__ __forceinline__ void hook(Acc& acc, const Unit& u, int t, int wr, int wc, int fr, int fq) const {
        asm volatile("" : "+v"(fr), "+v"(fq));
        const int br = (t >> 3) - 1;
        const bf16_t* pa = G + ((size_t)(u.pm * 12 + br * 4 + u.pn) * 8 + (wr * 4 + wc)) * 8192 + (fq * 16 + fr) * 8;
        const bf16_t* pb = pa + (size_t)4 * 512 * 128;
#pragma unroll
        for (int hb = 0; hb < 2; ++hb) {
            u32x4 ca[4][2], cb[4][2];
#pragma unroll
            for (int gg = 0; gg < 4; ++gg)
#pragma unroll
                for (int h = 0; h < 2; ++h) { ca[gg][h] = *(const u32x4*)(pa + ((hb * 4 + gg) * 2 + h) * 512); cb[gg][h] = *(const u32x4*)(pb + ((hb * 4 + gg) * 2 + h) * 512); }
#pragma unroll
            for (int gg = 0; gg < 4; ++gg)
#pragma unroll
                for (int q = 0; q < 4; ++q) {
                    const unsigned a0 = ca[gg][q >> 1][(q & 1) * 2], a1 = ca[gg][q >> 1][(q & 1) * 2 + 1], b0 = cb[gg][q >> 1][(q & 1) * 2], b1 = cb[gg][q >> 1][(q & 1) * 2 + 1];
                    f32x4 r; r[0] = bflo(a0) * __builtin_amdgcn_rcpf(bflo(b0)); r[1] = bfhi(a0) * __builtin_amdgcn_rcpf(bfhi(b0));
                    r[2] = bflo(a1) * __builtin_amdgcn_rcpf(bflo(b1)); r[3] = bfhi(a1) * __builtin_amdgcn_rcpf(bfhi(b1));
                    acc[hb][q >> 1][gg][q & 1] = acc[hb][q >> 1][gg][q & 1] * r;
                }
            asm volatile("" ::: "memory");
        }
    }
    __device__ __forceinline__ void operator()(const Acc& acc, const Unit& u, int wr, int wc, int fr, int fq) const {
        asm volatile("" : "+v"(fr), "+v"(fq));
        const int gpm = (u.pm < 64) ? 64 * half + u.pm : 128 + (u.pm - 64);
        const int cc = u.pn * 256 + 32 * wc + 8 * fq;
        const bf16_t* pc = G + ((size_t)(u.pm * 12 + 8 + u.pn) * 8 + (wr * 4 + wc)) * 8192 + (fq * 16 + fr) * 8;
        bf16_t* ob = MG + (size_t)(gpm * 256 + 64 * wr + fr) * 1024 + cc;
        u32x4 cg[8][2];
#pragma unroll
        for (int g = 0; g < 8; ++g)
#pragma unroll
            for (int h = 0; h < 2; ++h) cg[g][h] = *(const u32x4*)(pc + (g * 2 + h) * 512);
#pragma unroll
        for (int g = 0; g < 8; ++g) {
            const int ai = g >> 2, m = g & 3;
            bf16_t* orow = ob + (size_t)(128 * ai + 16 * m) * 1024;
#pragma unroll
            for (int h = 0; h < 2; ++h) { const u32x4 w = cg[g][h];
                const f32x4 g0 = {bflo(w[0]), bfhi(w[0]), bflo(w[1]), bfhi(w[1])}, g1 = {bflo(w[2]), bfhi(w[2]), bflo(w[3]), bfhi(w[3])};
                st8(orow + 128 * h, acc[ai][h][m][0] * g0, acc[ai][h][m][1] * g1); }
        }
    }
};

struct EpiRes {
    static constexpr bool HOOK = false;
    const float* base_lat; float* out_lat; const float* base_ctx; float* out_ctx; const float* gate;
    bf16_t* xa; const float* ng; const float* scl; float* rss;
    __device__ __forceinline__ void operator()(const Acc& acc, const Unit& u, int wr, int wc, int fr, int fq) const {
        asm volatile("" : "+v"(fr), "+v"(fq));
        const bool isctx = u.pm >= 128;
        const int colb = u.pn * 256 + 32 * wc + 4 * fq;
        const size_t off0 = (size_t)(64 * wr + fr) * 1024 + colb;
        const float* bs = (isctx ? base_ctx + (size_t)(u.pm - 128) * 256 * 1024 : base_lat + (size_t)u.pm * 256 * 1024) + off0;
        float* os = (isctx ? out_ctx + (size_t)(u.pm - 128) * 256 * 1024 : out_lat + (size_t)u.pm * 256 * 1024) + off0;
        const int b17 = isctx ? 16 : (u.pm >> 3);
        const float* gt = gate + (size_t)b17 * NMOD + colb;
        f32x4 g4[4], cb[4], nb[4], nm[4];
#pragma unroll
        for (int q = 0; q < 4; ++q) { g4[q] = *(const f32x4*)(gt + 128 * (q >> 1) + 16 * (q & 1)); cb[q] = *(const f32x4*)(bs + 128 * (q >> 1) + 16 * (q & 1)); }
        if (xa) {
#pragma unroll
            for (int q = 0; q < 4; ++q) nm[q] = *(const f32x4*)(ng + colb + 128 * (q >> 1) + 16 * (q & 1)) * (1.0f + *(const f32x4*)(scl + (size_t)b17 * NMOD + colb + 128 * (q >> 1) + 16 * (q & 1)));
        }
        bf16_t* xs = xa + (size_t)u.pm * 256 * 1024 + off0;
        float ss[8];
#pragma unroll
        for (int g = 0; g < 8; ++g) {
            const int ai = g >> 2, m = g & 3;
            if (g < 7) { const float* nbase = bs + (size_t)(128 * ((g + 1) >> 2) + 16 * ((g + 1) & 3)) * 1024;
#pragma unroll
                for (int q = 0; q < 4; ++q) nb[q] = *(const f32x4*)(nbase + 128 * (q >> 1) + 16 * (q & 1)); }
            float* orow = os + (size_t)(128 * ai + 16 * m) * 1024;
            float sq = 0.f;
#pragma unroll
            for (int q = 0; q < 4; ++q) {
                const f32x4 xn = cb[q] + g4[q] * acc[ai][q >> 1][m][q & 1];
                *(f32x4*)(orow + 128 * (q >> 1) + 16 * (q & 1)) = xn;
                if (xa) { st4(xs + (size_t)(128 * ai + 16 * m) * 1024 + 128 * (q >> 1) + 16 * (q & 1), xn * nm[q]); sq += (xn[0] * xn[0] + xn[1] * xn[1]) + (xn[2] * xn[2] + xn[3] * xn[3]); }
            }
            asm volatile("" : "+v"(sq));
            ss[g] = sq;
            asm volatile("" ::: "memory");
#pragma unroll
            for (int q = 0; q < 4; ++q) cb[q] = nb[q];
        }
        if (xa) {
            const int ln = fq * 16 + fr;
#pragma unroll
            for (int g = 0; g < 8; ++g) { float v = ss[g]; v += sx(v, 16, ln); v += sx(v, 32, ln);
                if (fq == 0) atomicAdd(rss + u.pm * 256 + 128 * (g >> 2) + 16 * (g & 3) + 64 * wr + fr, v); }
        }
    }
};

struct EpiGlu {
    static constexpr bool HOOK = false;
    bf16_t* H; const float *rss, *sw;
    __device__ __forceinline__ void operator()(const Acc& acc, const Unit& u, int wr, int wc, int fr, int fq) const {
        asm volatile("" : "+v"(fr), "+v"(fq));
        const float* swp = sw + (size_t)((u.pm >= 128) ? 16 : (u.pm >> 3)) * (2 * D_FF) + u.pn * 256 + 32 * wc + 4 * fq;
        f32x4 sg[2], su[2];
#pragma unroll
        for (int n = 0; n < 2; ++n) { sg[n] = *(const f32x4*)(swp + 16 * n); su[n] = *(const f32x4*)(swp + 128 + 16 * n); }
#pragma unroll
        for (int ai = 0; ai < 2; ++ai)
#pragma unroll
            for (int m = 0; m < 4; ++m) {
                const int row = u.pm * 256 + 128 * ai + 64 * wr + 16 * m + fr;
                const float rinv = rsqrtf(rss[row] * (1.0f / D) + EPS);
                bf16_t* base = H + (size_t)row * D_FF + u.pn * 128 + 32 * wc + 8 * fq;
                f32x4 hv[2];
#pragma unroll
                for (int n = 0; n < 2; ++n) { const f32x4 g = acc[ai][0][m][n] * rinv + sg[n], up = acc[ai][1][m][n] * rinv + su[n];
                    hv[n] = (f32x4){g[0] * sigmoidf_(g[0]) * up[0], g[1] * sigmoidf_(g[1]) * up[1], g[2] * sigmoidf_(g[2]) * up[2], g[3] * sigmoidf_(g[3]) * up[3]}; }
                st8(base, hv[0], hv[1]);
            }
    }
};

constexpr int A_K0 = 0, A_V0 = 24576, A_WSF = 73728, A_STG = 75776;
constexpr float THR = 6.0f;
__device__ __forceinline__ int crow(int r, int hi) { return (r & 3) + 8 * (r >> 2) + 4 * hi; }
__device__ __forceinline__ bf16x8 pack8(const f32x16& p, int b) {
    u32x4 w; w.x = pk2(p[b], p[b + 1]); w.y = pk2(p[b + 2], p[b + 3]); w.z = pk2(p[b + 4], p[b + 5]); w.w = pk2(p[b + 6], p[b + 7]);
    return __builtin_bit_cast(bf16x8, w);
}

template <int NDV, bool NOMAX>
__device__ __forceinline__ void attn_pass(const bf16_t* __restrict__ Qw, const char* __restrict__ Kt, const char* __restrict__ Vt, int nt, LAS unsigned char* lds, f32x16 (&o)[NDV]) {
    int tid = threadIdx.x; asm volatile("" : "+v"(tid));
    const int lane = tid & 63, r32 = lane & 31, hi = lane >> 5, wid = tid >> 6;
    constexpr int DV = NDV * 32, VT_BYTES = 64 * DV * 2, NVP = VT_BYTES / 8192;
    LAS float* wsf = (LAS float*)(lds + A_WSF + wid * 256);
    u32x4 kreg, vreg[NVP];
    const char* kg = Kt + tid * 16; const char* vg = Vt + tid * 16;
    LAS unsigned char* kl = lds + A_K0 + tid * 16; LAS unsigned char* vl = lds + A_V0 + tid * 16;
    const LAS unsigned char* kr = lds + A_K0 + hi * 1024 + r32 * 16;
    const LAS unsigned char* vr = lds + A_V0 + (hi * DV + r32) * 16;
#define AT_LOAD(j) do { kreg = *(const u32x4*)(kg + (size_t)(j) * 8192); _Pragma("unroll") for (int i_ = 0; i_ < NVP; ++i_) vreg[i_] = *(const u32x4*)(vg + (size_t)(j) * VT_BYTES + i_ * 8192); } while (0)
#define AT_STORE(slot) do { *(LAS u32x4*)(kl + (slot) * 8192) = kreg; _Pragma("unroll") for (int i_ = 0; i_ < NVP; ++i_) *(LAS u32x4*)(vl + (slot) * 16384 + i_ * 8192) = vreg[i_]; } while (0)
#define AT_QK(P0, P1, slot) do { const LAS unsigned char* kb_ = kr + (slot) * 8192; P0 = negm; P1 = negm; \
        _Pragma("unroll") for (int d0 = 0; d0 < 4; ++d0) { const bf16x8 k0_ = *(const LAS bf16x8*)(kb_ + d0 * 2048), k1_ = *(const LAS bf16x8*)(kb_ + d0 * 2048 + 512); \
            P0 = __builtin_amdgcn_mfma_f32_32x32x16_bf16(k0_, qr[d0], P0, 0, 0, 0); P1 = __builtin_amdgcn_mfma_f32_32x32x16_bf16(k1_, qr[d0], P1, 0, 0, 0); } } while (0)
#define AT_EXP(P0, P1) do { float ps_ = 0.f; _Pragma("unroll") for (int r = 0; r < 16; ++r) { P0[r] = __builtin_amdgcn_exp2f(P0[r]); P1[r] = __builtin_amdgcn_exp2f(P1[r]); ps_ += P0[r] + P1[r]; } l += ps_; \
        pa[0] = pack8(P0, 0); pa[1] = pack8(P0, 8); pa[2] = pack8(P1, 0); pa[3] = pack8(P1, 8); } while (0)
#define AT_PV(slot) do { const LAS unsigned char* vb_ = vr + (slot) * 16384; __builtin_amdgcn_s_setprio(1); \
        _Pragma("unroll") for (int d0 = 0; d0 < NDV; ++d0) _Pragma("unroll") for (int s_ = 0; s_ < 4; ++s_) { const bf16x8 v_ = *(const LAS bf16x8*)(vb_ + s_ * (2 * DV * 16) + d0 * 512); \
            o[d0] = __builtin_amdgcn_mfma_f32_32x32x16_bf16(pa[s_], v_, o[d0], 0, 0, 0); } __builtin_amdgcn_s_setprio(0); } while (0)
#define AT_MAX(P0, P1) do { if (NOMAX) break; float rm_ = fmaxf(P0[0], P1[0]); _Pragma("unroll") for (int r = 1; r < 16; ++r) rm_ = fmaxf(rm_, fmaxf(P0[r], P1[r])); rm_ = fmaxf(rm_, sx(rm_, 32, lane)); \
        if (__any(rm_ > THR)) { const float dl_ = fmaxf(rm_, 0.f); mref += dl_; _Pragma("unroll") for (int r = 0; r < 16; ++r) { P0[r] -= dl_; P1[r] -= dl_; negm[r] = -mref; } \
            const float f_ = __builtin_amdgcn_exp2f(-dl_); l *= f_; if (hi == 0) wsf[r32] = f_; \
            _Pragma("unroll") for (int r = 0; r < 16; ++r) { const float fr_ = wsf[crow(r, hi)]; _Pragma("unroll") for (int d0 = 0; d0 < NDV; ++d0) o[d0][r] *= fr_; } } } while (0)
    AT_LOAD(0);
    bf16x8 qr[4];
#pragma unroll
    for (int d0 = 0; d0 < 4; ++d0) qr[d0] = *(const bf16x8*)(Qw + r32 * 64 + d0 * 16 + hi * 8);
    AT_STORE(0);
    AT_LOAD(1);
    AT_STORE(1);
    if (nt > 2) AT_LOAD(2);
    __syncthreads();
    float mref = 0.f, l = 0.f;
#pragma unroll
    for (int d0 = 0; d0 < NDV; ++d0)
#pragma unroll
        for (int r = 0; r < 16; ++r) o[d0][r] = 0.f;
    f32x16 negm;
#pragma unroll
    for (int r = 0; r < 16; ++r) negm[r] = 0.f;
    f32x16 pA0, pA1, pB0, pB1; bf16x8 pa[4];
    AT_QK(pA0, pA1, 0);
    if (!NOMAX) {
        float rm = fmaxf(pA0[0], pA1[0]);
#pragma unroll
        for (int r = 1; r < 16; ++r) rm = fmaxf(rm, fmaxf(pA0[r], pA1[r]));
        rm = fmaxf(rm, sx(rm, 32, lane));
        mref = rm;
#pragma unroll
        for (int r = 0; r < 16; ++r) { pA0[r] -= rm; pA1[r] -= rm; negm[r] = -mref; }
    }
    int s0 = 0, s1 = 1, s2 = 2;
#define AT_ROT() do { const int t_ = s0; s0 = s1; s1 = s2; s2 = t_; } while (0)
#define AT_STEP(C0, C1, N0, N1, t, HAS2, HAS3) do { \
        AT_QK(N0, N1, s1); \
        AT_EXP(C0, C1); \
        AT_PV(s0); \
        AT_MAX(N0, N1); \
        if (HAS2) AT_STORE(s2); \
        if (HAS3) AT_LOAD((t) + 3); \
        __syncthreads(); AT_ROT(); } while (0)
    int t = 0;
    for (; t + 4 <= nt - 2; t += 2) {
        AT_STEP(pA0, pA1, pB0, pB1, t, true, true);
        AT_STEP(pB0, pB1, pA0, pA1, t + 1, true, true);
    }
    AT_STEP(pA0, pA1, pB0, pB1, t, true, (t + 3 < nt));
    AT_STEP(pB0, pB1, pA0, pA1, t + 1, (t + 3 < nt), false);
    t += 2;
    for (; t + 2 <= nt - 2; t += 2) { }
    AT_STEP(pA0, pA1, pB0, pB1, t, false, false);
    AT_EXP(pB0, pB1);
    AT_PV(s0);
    __syncthreads();
    l += sx(l, 32, lane);
    const float li = 1.0f / l;
    if (hi == 0) wsf[r32] = li;
#pragma unroll
    for (int r = 0; r < 16; ++r) { const float s = wsf[crow(r, hi)];
#pragma unroll
        for (int d0 = 0; d0 < NDV; ++d0) o[d0][r] *= s; }
#undef AT_LOAD
#undef AT_STORE
#undef AT_QK
#undef AT_EXP
#undef AT_PV
#undef AT_MAX
#undef AT_ROT
#undef AT_STEP
}

template <int NDV, bool FIXED>
__device__ __forceinline__ void attn_pass_simple(const bf16_t* __restrict__ Qw, const char* __restrict__ Kt, const char* __restrict__ Vt, int nt, LAS unsigned char* lds, f32x16 (&o)[NDV], float kmax2) {
    int tid = threadIdx.x; asm volatile("" : "+v"(tid));
    const int lane = tid & 63, r32 = lane & 31, hi = lane >> 5, wid = tid >> 6;
    constexpr int DV = NDV * 32, VT_BYTES = 64 * DV * 2, NVP = VT_BYTES / 8192;
    LAS float* wsf = (LAS float*)(lds + A_WSF + wid * 256);
    u32x4 kreg, vreg[NVP];
    kreg = *(const u32x4*)(Kt + tid * 16);
#pragma unroll
    for (int i = 0; i < NVP; ++i) vreg[i] = *(const u32x4*)(Vt + (i * 512 + tid) * 16);
    bf16x8 qr[4];
#pragma unroll
    for (int d0 = 0; d0 < 4; ++d0) qr[d0] = *(const bf16x8*)(Qw + r32 * 64 + d0 * 16 + hi * 8);
    *(LAS u32x4*)(lds + A_K0 + tid * 16) = kreg;
#pragma unroll
    for (int i = 0; i < NVP; ++i) *(LAS u32x4*)(lds + A_V0 + (i * 512 + tid) * 16) = vreg[i];
    __syncthreads();
    float mref = 0.f, l = 0.f;
#pragma unroll
    for (int d0 = 0; d0 < NDV; ++d0)
#pragma unroll
        for (int r = 0; r < 16; ++r) o[d0][r] = 0.f;
    f32x16 negm;
#pragma unroll
    for (int r = 0; r < 16; ++r) negm[r] = 0.f;
    if (FIXED) {
        float qn2 = 0.f;
#pragma unroll
        for (int d0 = 0; d0 < 4; ++d0) { const u32x4 w = __builtin_bit_cast(u32x4, qr[d0]);
#pragma unroll
            for (int e = 0; e < 4; ++e) { const float a = bflo(w[e]), b = bfhi(w[e]); qn2 += a * a + b * b; } }
        qn2 += sx(qn2, 32, lane);
        mref = sqrtf(qn2 * kmax2) * 1.02f + 0.5f;
#pragma unroll
        for (int r = 0; r < 16; ++r) negm[r] = -mref;
    }
    for (int t = 0; t < nt; ++t) {
        const int cur = t & 1;
        const bool more = (t + 1 < nt);
        if (more) {
            kreg = *(const u32x4*)(Kt + (size_t)(t + 1) * 8192 + tid * 16);
#pragma unroll
            for (int i = 0; i < NVP; ++i) vreg[i] = *(const u32x4*)(Vt + (size_t)(t + 1) * VT_BYTES + (i * 512 + tid) * 16);
        }
        const LAS unsigned char* kb = lds + A_K0 + cur * 8192 + hi * 1024 + r32 * 16;
        f32x16 p0 = negm, p1 = negm;
        __builtin_amdgcn_s_setprio(1);
#pragma unroll
        for (int d0 = 0; d0 < 4; ++d0) {
            const bf16x8 k0 = *(const LAS bf16x8*)(kb + d0 * 2048), k1 = *(const LAS bf16x8*)(kb + d0 * 2048 + 512);
            p0 = __builtin_amdgcn_mfma_f32_32x32x16_bf16(k0, qr[d0], p0, 0, 0, 0);
            p1 = __builtin_amdgcn_mfma_f32_32x32x16_bf16(k1, qr[d0], p1, 0, 0, 0);
        }
        __builtin_amdgcn_s_setprio(0);
        if (!FIXED) {
        float rm = fmaxf(p0[0], p1[0]);
#pragma unroll
        for (int r = 1; r < 16; ++r) rm = fmaxf(rm, fmaxf(p0[r], p1[r]));
        rm = fmaxf(rm, sx(rm, 32, lane));
        if (t == 0) {
            mref = rm;
#pragma unroll
            for (int r = 0; r < 16; ++r) { p0[r] -= rm; p1[r] -= rm; negm[r] = -mref; }
        } else if (__any(rm > THR)) {
            const float dl = fmaxf(rm, 0.f);
            mref += dl;
#pragma unroll
            for (int r = 0; r < 16; ++r) { p0[r] -= dl; p1[r] -= dl; negm[r] = -mref; }
            const float f = __builtin_amdgcn_exp2f(-dl);
            l *= f;
            if (hi == 0) wsf[r32] = f;
#pragma unroll
            for (int r = 0; r < 16; ++r) { const float fr_ = wsf[crow(r, hi)];
#pragma unroll
                for (int d0 = 0; d0 < NDV; ++d0) o[d0][r] *= fr_; }
        }
        }
        float ps = 0.f;
#pragma unroll
        for (int r = 0; r < 16; ++r) { p0[r] = __builtin_amdgcn_exp2f(p0[r]); p1[r] = __builtin_amdgcn_exp2f(p1[r]); ps += p0[r] + p1[r]; }
        l += ps;
        bf16x8 pa[4];
        pa[0] = pack8(p0, 0); pa[1] = pack8(p0, 8); pa[2] = pack8(p1, 0); pa[3] = pack8(p1, 8);
        const LAS unsigned char* vb = lds + A_V0 + cur * 16384 + (hi * DV + r32) * 16;
        __builtin_amdgcn_s_setprio(1);
#pragma unroll
        for (int d0 = 0; d0 < NDV; ++d0)
#pragma unroll
            for (int s = 0; s < 4; ++s) {
                const bf16x8 v = *(const LAS bf16x8*)(vb + s * (2 * DV * 16) + d0 * 512);
                o[d0] = __builtin_amdgcn_mfma_f32_32x32x16_bf16(pa[s], v, o[d0], 0, 0, 0);
            }
        __builtin_amdgcn_s_setprio(0);
        if (more) {
            *(LAS u32x4*)(lds + A_K0 + (cur ^ 1) * 8192 + tid * 16) = kreg;
#pragma unroll
            for (int i = 0; i < NVP; ++i) *(LAS u32x4*)(lds + A_V0 + (cur ^ 1) * 16384 + (i * 512 + tid) * 16) = vreg[i];
        }
        __syncthreads();
    }
    l += sx(l, 32, lane);
    const float li = 1.0f / l;
    if (hi == 0) wsf[r32] = li;
#pragma unroll
    for (int r = 0; r < 16; ++r) { const float s = wsf[crow(r, hi)];
#pragma unroll
        for (int d0 = 0; d0 < NDV; ++d0) o[d0][r] *= s; }
}

struct Params {
    const float *x, *c, *ctx, *c_ctx, *w_mod, *b_mod, *norm1_g, *norm2_g, *w_in, *lam_q1, *lam_k1, *lam_q2, *lam_k2, *subln_g, *q_norm_g, *k_norm_g, *conv_w,
        *w_a, *w_b, *w_c, *w_out, *w_gu, *w_dn, *final_g;
    float* out; unsigned char* ws;
    int use_cg; int pad;
};

__device__ __forceinline__ int rowmap(int kind, int c) {
    if (kind == 1) {
        if (c < 1024 || (c >= 1536 && c < 2304)) { const int unit = c >> 8, lc = c & 255, chunk = lc >> 6, d = lc & 63; return (unit << 8) + ((d >> 5) << 7) + (chunk << 5) + (d & 31); }
        if (c >= 2816 && c < 3840) { const int isu = (c >= 3328) ? 1 : 0; const int ch = c - (isu ? 3328 : 2816); return 2816 + ((ch >> 7) << 8) + (isu << 7) + ((ch & 127) & ~31) + ip32(ch & 31); }
        if (c >= 2304) return (c & ~31) + ip32(c & 31);
        return c;
    }
    if (kind == 2) {
        const int isu = (c >= D_FF) ? 1 : 0; const int j = c - (isu ? D_FF : 0); return ((j >> 7) << 8) + (isu << 7) + ((j & 127) & ~31) + ip32(j & 31);
    }
    if (kind == 3) return (c & ~31) + ip32(c & 31);
    return c;
}
__device__ __forceinline__ void transpose_item(const float* __restrict__ W, int N, bf16_t* WT, int ldk, int koff, int kind, LAS float* scr, int item, int lane) {
    const int nblk = N / 32, kb = item / nblk, nb = item % nblk, k0 = 64 * kb, n0 = 32 * nb;
    f32x4 tv[8];
#pragma unroll
    for (int i = 0; i < 8; ++i) tv[i] = *(const f32x4*)(W + (size_t)(k0 + (lane >> 3) + 8 * i) * N + n0 + (lane & 7) * 4);
#pragma unroll
    for (int i = 0; i < 8; ++i) { LAS float* d = scr + ((lane >> 3) + 8 * i) * 33 + (lane & 7) * 4; d[0] = tv[i][0]; d[1] = tv[i][1]; d[2] = tv[i][2]; d[3] = tv[i][3]; }
    asm volatile("s_waitcnt lgkmcnt(0)" ::: "memory");
    const int c = lane & 7;
#pragma unroll
    for (int j = 0; j < 4; ++j) { const int n = (lane >> 3) + 8 * j; const LAS float* s = scr + (8 * c) * 33 + n;
        u32x4 o; o.x = pk2(s[0 * 33], s[1 * 33]); o.y = pk2(s[2 * 33], s[3 * 33]); o.z = pk2(s[4 * 33], s[5 * 33]); o.w = pk2(s[6 * 33], s[7 * 33]);
        *(u32x4*)(WT + (size_t)rowmap(kind, n0 + n) * ldk + koff + k0 + 8 * c) = o; }
    asm volatile("s_waitcnt lgkmcnt(0)" ::: "memory");
}
__device__ __forceinline__ float wave_sum(float v, int lane) {
#pragma unroll
    for (int o = 1; o < 64; o <<= 1) v += sx(v, o, lane);
    return v;
}
__device__ __forceinline__ void norm_mod_row(const float* xrow, const float* g, const float* shift, const float* scale, bf16_t* orow, int lane) {
    f32x4 v[4]; float s = 0.f;
#pragma unroll
    for (int j = 0; j < 4; ++j) { v[j] = *(const f32x4*)(xrow + 4 * lane + 256 * j); s += (v[j][0] * v[j][0] + v[j][1] * v[j][1]) + (v[j][2] * v[j][2] + v[j][3] * v[j][3]); }
    const float rinv = rsqrtf(wave_sum(s, lane) * (1.0f / D) + EPS);
#pragma unroll
    for (int j = 0; j < 4; ++j) {
        const f32x4 gg = *(const f32x4*)(g + 4 * lane + 256 * j), sh = *(const f32x4*)(shift + 4 * lane + 256 * j), sc = *(const f32x4*)(scale + 4 * lane + 256 * j);
        st4(orow + 4 * lane + 256 * j, (v[j] * rinv * gg) * (1.0f + sc) + sh);
    }
}

__device__ __forceinline__ void transpose_layer(const Params& P, unsigned char* ws, int l, int gw, int NGW, LAS float* scr, int lane) {
    constexpr int I_IN = 16 * 216, I_BR = 8 * 32, I_OUT = 16 * 32, I_GU = 16 * 176, I_DN = 44 * 32;
    constexpr int I_LAYER = I_IN + 3 * I_BR + I_OUT + I_GU + I_DN;
    unsigned char* wt = ws + (size_t)l * WT_LAYER;
    for (int it = gw; it < I_LAYER; it += NGW) {
        int r = it;
        if (r < I_IN) { transpose_item(P.w_in + (size_t)l * D * D_IN, D_IN, (bf16_t*)(wt + OFF_WIN), D, 0, 1, scr, r, lane); continue; } r -= I_IN;
        if (r < I_BR) { transpose_item(P.w_a + (size_t)l * 512 * D, D, (bf16_t*)(wt + OFF_WBR), 1536, 0, 3, scr, r, lane); continue; } r -= I_BR;
        if (r < I_BR) { transpose_item(P.w_b + (size_t)l * 512 * D, D, (bf16_t*)(wt + OFF_WBR), 1536, 512, 3, scr, r, lane); continue; } r -= I_BR;
        if (r < I_BR) { transpose_item(P.w_c + (size_t)l * 512 * D, D, (bf16_t*)(wt + OFF_WBR), 1536, 1024, 3, scr, r, lane); continue; } r -= I_BR;
        if (r < I_OUT) { transpose_item(P.w_out + (size_t)l * D * D, D, (bf16_t*)(wt + OFF_WOUT), D, 0, 0, scr, r, lane); continue; } r -= I_OUT;
        if (r < I_GU) { transpose_item(P.w_gu + (size_t)l * D * 2 * D_FF, 2 * D_FF, (bf16_t*)(wt + OFF_WGU), D, 0, 2, scr, r, lane); continue; } r -= I_GU;
        transpose_item(P.w_dn + (size_t)l * D_FF * D, D, (bf16_t*)(wt + OFF_WDN), D_FF, 0, 0, scr, r, lane);
    }
}
__device__ __forceinline__ void sw_sets(unsigned char* ws, const float* MOD, float* SWIN, float* SWGU, int set_lo, int set_hi, int vw, int nvw, LAS unsigned char* lds, int tid, int lane) {
    LAS float* S = (LAS float*)lds;
    for (int set = set_lo; set < set_hi; ++set) {
        const int ls = (set == 0) ? 0 : 1, idx = (set == 1) ? 0 : 3, ncols = (set == 1) ? D_IN : 2 * D_FF;
        const bf16_t* W = (const bf16_t*)(ws + (size_t)ls * WT_LAYER + ((set == 1) ? OFF_WIN : OFF_WGU));
        float* outp = (set == 1) ? SWIN : SWGU + (size_t)ls * 17 * (2 * D_FF);
        for (int i = tid; i < 17 * 1024; i += 512) S[i] = MOD[(size_t)(ls * 17 + (i >> 10)) * NMOD + idx * 1024 + (i & 1023)];
        __syncthreads();
        for (int c = vw; c < ncols; c += nvw) {
            const bf16_t* wrow = W + (size_t)c * 1024 + lane * 16;
            const u32x4 w0 = *(const u32x4*)wrow, w1 = *(const u32x4*)(wrow + 8);
            float wv[16];
#pragma unroll
            for (int q = 0; q < 4; ++q) { wv[2 * q] = bflo(w0[q]); wv[2 * q + 1] = bfhi(w0[q]); wv[8 + 2 * q] = bflo(w1[q]); wv[8 + 2 * q + 1] = bfhi(w1[q]); }
#pragma unroll 1
            for (int r = 0; r < 17; ++r) {
                float a = 0.f;
#pragma unroll
                for (int q = 0; q < 4; ++q) { const f32x4 sv = *(const LAS f32x4*)(S + r * 1024 + lane * 16 + 4 * q); a += (sv[0] * wv[4 * q] + sv[1] * wv[4 * q + 1]) + (sv[2] * wv[4 * q + 2] + sv[3] * wv[4 * q + 3]); }
                a = wave_sum(a, lane);
                if (lane == 0) outp[(size_t)r * ncols + c] = a;
            }
        }
        __syncthreads();
    }
}

#define XB_TMO      128
#define XB_XCNT(j)  (256  + 64 * (j))
#define XB_XSUB(j)  (1280 + 64 * (j))
#define XB_XGEN(j)  (2304 + 64 * (j))
#define XB_TOP      3328
#define XB_TOPGEN   3392
#define XCD_BAR_WORDS 3456
#define XB_SPIN_CAP (1u << 18)
__device__ __forceinline__ unsigned xb_ld(unsigned* p)              { return __hip_atomic_load(p, __ATOMIC_RELAXED, __HIP_MEMORY_SCOPE_AGENT); }
__device__ __forceinline__ unsigned xb_add(unsigned* p, unsigned v) { return __hip_atomic_fetch_add(p, v, __ATOMIC_RELAXED, __HIP_MEMORY_SCOPE_AGENT); }
__device__ __forceinline__ unsigned xb_xcc_id() { return (unsigned)__builtin_amdgcn_s_getreg((3 << 11) | 20) & 0xFu; }
#define XB_SPIN(cond, bar) do { unsigned _sp = 0; while (cond) { __builtin_amdgcn_s_sleep(1); \
    if ((++_sp & 255u) == 0u) { if (xb_ld(&(bar)[XB_TMO])) break; if (_sp > XB_SPIN_CAP) { atomicAdd(&(bar)[XB_TMO], 1u); break; } } } } while (0)
struct XcdBarrier { unsigned* bar; unsigned x; volatile LAS unsigned* st; };
__device__ __forceinline__ XcdBarrier xcd_barrier_post(unsigned* bar, volatile LAS unsigned* st) {
    XcdBarrier b; b.bar = bar; b.x = xb_xcc_id(); b.st = st;
    if (threadIdx.x == 0) (void)xb_add(&bar[XB_XCNT(b.x)], 1u);
    return b;
}
__device__ __forceinline__ void xcd_barrier_complete(unsigned* bar, unsigned x, unsigned& nloc, unsigned& nx) {
    const unsigned G = gridDim.x * gridDim.y * gridDim.z;
    unsigned sum, cnt, mine, sp = 0u;
    for (;;) {
        sum = 0u; cnt = 0u; mine = 0u;
#pragma unroll
        for (unsigned j = 0; j < 16; ++j) { const unsigned c = xb_ld(&bar[XB_XCNT(j)]); sum += c; cnt += (c > 0u) ? 1u : 0u; mine = (j == x) ? c : mine; }
        if (sum == G) break;
        __builtin_amdgcn_s_sleep(1);
        if ((++sp & 255u) == 0u) { if (xb_ld(&bar[XB_TMO])) break; if (sp > XB_SPIN_CAP) { atomicAdd(&bar[XB_TMO], 1u); break; } }
    }
    nloc = mine > 0u ? mine : 1u; nx = cnt > 0u ? cnt : 1u;
}
__device__ __forceinline__ void xcd_barrier(const XcdBarrier& b) {
    asm volatile("s_waitcnt vmcnt(0)" ::: "memory");
    __syncthreads();
    if (threadIdx.x == 0) {
        unsigned* bar = b.bar;
        __builtin_amdgcn_s_waitcnt(0);
        unsigned nloc = b.st[0], nx = b.st[1];
        if (nloc == 0u) { xcd_barrier_complete(bar, b.x, nloc, nx); b.st[0] = nloc; b.st[1] = nx; }
        const unsigned old = xb_add(&bar[XB_XSUB(b.x)], 1u);
        const unsigned gen = old / nloc;
        if (old + 1u == (gen + 1u) * nloc) {
            __builtin_amdgcn_fence(__ATOMIC_RELEASE, "agent");
            asm volatile("s_waitcnt vmcnt(0)" ::: "memory");
            const unsigned og = xb_add(&bar[XB_TOP], 1u);
            const unsigned tg = og / nx;
            if (og + 1u == (tg + 1u) * nx) xb_add(&bar[XB_TOPGEN], 1u);
            else XB_SPIN(xb_ld(&bar[XB_TOPGEN]) == tg, bar);
            __builtin_amdgcn_fence(__ATOMIC_ACQUIRE, "agent");
            xb_add(&bar[XB_XGEN(b.x)], 1u);
            asm volatile("s_waitcnt vmcnt(0)" ::: "memory");
        } else {
            XB_SPIN(xb_ld(&bar[XB_XGEN(b.x)]) == gen, bar);
            __builtin_amdgcn_fence(__ATOMIC_ACQUIRE, "agent");
            asm volatile("s_waitcnt vmcnt(0)" ::: "memory");
        }
    }
    __syncthreads();
}

constexpr int LDS_BYTES = 147456;
#ifndef PHASE_MASK
#define PHASE_MASK 0xffff
#endif
#define PHASE_ON(k) (((PHASE_MASK) >> (k)) & 1)
#ifndef ATT_REP
#define ATT_REP 1
#endif
#ifndef P1_REP
#define P1_REP 1
#endif

__global__ void __launch_bounds__(512) fwd_kernel(Params P) {
    extern __shared__ __attribute__((aligned(16))) unsigned char lds_raw[];
    LAS unsigned char* lds = (LAS unsigned char*)lds_raw;
    cg::grid_group grid = cg::this_grid();
    const int G = gridDim.x, bx = blockIdx.x;
    const int vcu = (G % 8 == 0) ? (bx % 8) * (G / 8) + bx / 8 : bx;
    unsigned char* ws = P.ws;
    float* MOD = (float*)(ws + WS_MOD);
    float* cosT = (float*)(ws + WS_ROPE); float* sinT = cosT + 1024;
    float* CTXS = (float*)(ws + WS_CTXS);
    bf16_t* XN = (bf16_t*)(ws + WS_XN);
    bf16_t *AQ = (bf16_t*)(ws + B_AQ), *BQ = (bf16_t*)(ws + B_BQ), *AK = (bf16_t*)(ws + B_AK), *AV = (bf16_t*)(ws + B_AV), *BK = (bf16_t*)(ws + B_BK), *BV = (bf16_t*)(ws + B_BV);
    bf16_t *CB = (bf16_t*)(ws + B_CB), *PB = (bf16_t*)(ws + B_PB), *GT = (bf16_t*)(ws + B_G), *Y = (bf16_t*)(ws + B_Y);
    float* SCR = (float*)(ws + B_SCR);
    bf16_t *XN2 = (bf16_t*)(ws + B_XN2), *HB = (bf16_t*)(ws + B_H);
    float *SWGU = (float*)(ws + WS_SWGU), *SWIN = (float*)(ws + WS_SWIN), *RSS = (float*)(ws + WS_RSS);
    unsigned* QKMAX = (unsigned*)(ws + WS_RSS + 960 * 1024);

    unsigned* barw = (unsigned*)(ws + WS_BAR);
    volatile LAS unsigned* bst = (volatile LAS unsigned*)(lds + LDS_BYTES - 64);
    if (threadIdx.x < 2) bst[threadIdx.x] = 0u;
    for (int i = bx * 512 + threadIdx.x; i < 3 * M_ALL; i += G * 512) RSS[i] = 0.f;
    if (bx == 0) QKMAX[threadIdx.x] = 0u;
    __syncthreads();
    const XcdBarrier xbar = xcd_barrier_post(barw, bst);
#define GSYNC() xcd_barrier(xbar)
    {
        int tid = threadIdx.x; asm volatile("" : "+v"(tid)); const int lane = tid & 63, wid = __builtin_amdgcn_readfirstlane(tid >> 6); (void)lane; (void)wid;
        if (PHASE_ON(0)) {
        transpose_layer(P, ws, 0, vcu * 8 + wid, G * 8, (LAS float*)(lds + wid * 16384), lane);
        __syncthreads();
        if (bx < 192) {
            LAS float* S = (LAS float*)lds;
            for (int i = tid; i < 17 * 1024; i += 512) { const float v = (i < 16384) ? P.c[i] : P.c_ctx[i - 16384]; S[i] = v * sigmoidf_(v); }
            __syncthreads();
            const int l = bx / 96, n0 = (bx % 96) * 64;
            const float* Wm = P.w_mod + (size_t)l * D * NMOD + n0 + lane;
            float a17[17];
#pragma unroll
            for (int r = 0; r < 17; ++r) a17[r] = 0.f;
            for (int k = wid * 128; k < wid * 128 + 128; k += 4) {
                const float w0 = Wm[(size_t)k * NMOD], w1 = Wm[(size_t)(k + 1) * NMOD], w2 = Wm[(size_t)(k + 2) * NMOD], w3 = Wm[(size_t)(k + 3) * NMOD];
#pragma unroll
                for (int r = 0; r < 17; ++r) { const f32x4 s = *(const LAS f32x4*)(S + r * 1024 + k); a17[r] += (s[0] * w0 + s[1] * w1) + (s[2] * w2 + s[3] * w3); }
            }
            LAS float* R = (LAS float*)(lds + 69632);
#pragma unroll
            for (int r = 0; r < 17; ++r) R[(wid * 17 + r) * 64 + lane] = a17[r];
            __syncthreads();
            for (int i = tid; i < 17 * 64; i += 512) { const int r = i >> 6, col = i & 63; float s = 0.f;
#pragma unroll
                for (int w = 0; w < 8; ++w) s += R[(w * 17 + r) * 64 + col];
                MOD[(size_t)(l * 17 + r) * NMOD + n0 + col] = s + P.b_mod[l * NMOD + n0 + col]; }
            __syncthreads();
        }
        if (bx == G - 1) {
            for (int i = tid; i < 1024; i += 512) {
                const int pos = i >> 4, f = i & 15;
                const float inv = exp2f(-(float)f * (13.287712379549449f / 16.0f));
                const float ang = (float)pos * inv;
                const double xd = (double)ang, nn = __builtin_rint(xd * 0.63661977236758134308), r = (xd - nn * 1.57079632679489655800) - nn * 6.123233995736766e-17, r2 = r * r;
                const double sn = r * (1.0 + r2 * (-1.0 / 6 + r2 * (1.0 / 120 + r2 * (-1.0 / 5040 + r2 * (1.0 / 362880 + r2 * (-1.0 / 39916800 + r2 * (1.0 / 6227020800.0)))))));
                const double cs = 1.0 + r2 * (-0.5 + r2 * (1.0 / 24 + r2 * (-1.0 / 720 + r2 * (1.0 / 40320 + r2 * (-1.0 / 3628800 + r2 * (1.0 / 479001600.0 + r2 * (-1.0 / 87178291200.0)))))));
                const int q = ((int)nn) & 3;
                const double sv = (q == 0) ? sn : (q == 1) ? cs : (q == 2) ? -sn : -cs;
                const double cv = (q == 0) ? cs : (q == 1) ? -sn : (q == 2) ? -cs : sn;
                cosT[i] = (float)cv; sinT[i] = (float)sv;
            }
        }
        }
    }
    if (P.use_cg) grid.sync();
    GSYNC();

    const int f0 = (G == 256) ? 64 : 0;
    {
        int tid = threadIdx.x; asm volatile("" : "+v"(tid)); const int lane = tid & 63, wid = __builtin_amdgcn_readfirstlane(tid >> 6);
        sw_sets(ws, MOD, SWIN, SWGU, 0, 1, vcu * 8 + wid, G * 8, lds, tid, lane);
    }

    for (int l = 0; l < 2; ++l) {
        unsigned char* wt = ws + (size_t)l * WT_LAYER;
        const float* modl = MOD + (size_t)l * 17 * NMOD;
        const float* xlat = (l == 0) ? P.x : P.out;
        const float* xctx = (l == 0) ? P.ctx : CTXS;
        const int nctx_tiles = (l == 0) ? 16 : 0;
        if (l == 0) { int tid = threadIdx.x; asm volatile("" : "+v"(tid)); const int lane = tid & 63, wid = __builtin_amdgcn_readfirstlane(tid >> 6); (void)lane; (void)wid;
        for (int row = vcu * 8 + wid; row < M_ALL; row += G * 8) {
            const bool isctx = row >= M_LAT;
            const float* xr = isctx ? xctx + (size_t)(row - M_LAT) * D : xlat + (size_t)row * D;
            const float* mr = modl + (size_t)(isctx ? 16 : (row >> 11)) * NMOD;
            norm_mod_row(xr, P.norm1_g + l * D, mr, mr + 1024, XN + (size_t)row * D, lane);
        } }
        if (l == 0) GSYNC();
        for (int half = 0; half < 2; ++half) {
            {
                pg8::Gemm g{XN, (const bf16_t*)(wt + OFF_WIN), D};
                pg8::Order S; S.init(64, 8, 64 * half, 128 + 8 * half, D_IN, G, bx, l == 1);
                EpiIn E{AQ, BQ, AK, AV, BK, BV, CB, PB, GT, cosT, sinT, P.q_norm_g + l * 64, P.k_norm_g + l * 64, (l == 1) ? RSS + M_ALL : nullptr, SWIN, QKMAX + l * 256};
                for (int rep = 0; rep < P1_REP; ++rep) if (PHASE_ON(1)) pg8::gemm_phase<EpiIn>(lds, g, S, E);
            }
            GSYNC();
            {
                int tid = threadIdx.x; asm volatile("" : "+v"(tid)); const int lane = tid & 63, wid = __builtin_amdgcn_readfirstlane(tid >> 6); (void)lane; (void)wid;
                const float* cw = P.conv_w + l * 1536;
                for (int idx = bx * 512 + tid; idx < ((l == 0) ? HROWS : 16384) * 64; idx += G * 512) {
                    const int rr_ = idx >> 6, c8 = (idx & 63) * 8, rowl = (rr_ < 16384) ? rr_ : rr_ + half * 2048;
                    bool hp, hn;
                    if (rowl < 16384) { const int t = rowl & 2047; hp = t > 0; hn = t < 2047; } else { const int j = (rowl - 16384) & 255; hp = j > 0; hn = j < 255; }
                    const u32x4 z4 = {0u, 0u, 0u, 0u};
                    const u32x4 pc = *(const u32x4*)(PB + (size_t)rowl * 512 + c8);
                    const u32x4 pp = hp ? *(const u32x4*)(PB + (size_t)(rowl - 1) * 512 + c8) : z4;
                    const u32x4 pn = hn ? *(const u32x4*)(PB + (size_t)(rowl + 1) * 512 + c8) : z4;
                    const u32x4 cb = *(const u32x4*)(CB + (size_t)rowl * 512 + c8);
                    u32x4 o;
#pragma unroll
                    for (int q = 0; q < 4; ++q) {
                        const int ch = c8 + 2 * q;
                        const float y0 = bflo(cb[q]) * (cw[ch] * bflo(pp[q]) + cw[512 + ch] * bflo(pc[q]) + cw[1024 + ch] * bflo(pn[q]));
                        const float y1 = bfhi(cb[q]) * (cw[ch + 1] * bfhi(pp[q]) + cw[512 + ch + 1] * bfhi(pc[q]) + cw[1024 + ch + 1] * bfhi(pn[q]));
                        o[q] = pk2(y0, y1);
                    }
                    *(u32x4*)(Y + (size_t)rowl * 1536 + 1024 + c8) = o;
                }
                const float lam_init = (l == 0) ? 0.2f : 0.35550906f;
                const float d1 = wave_sum(P.lam_q1[l * 64 + lane] * P.lam_k1[l * 64 + lane], lane), d2 = wave_sum(P.lam_q2[l * 64 + lane] * P.lam_k2[l * 64 + lane], lane);
                const float lam = expf(d1) - expf(d2) + lam_init, oml = 1.0f - lam_init;
                float mq = fabsf(P.q_norm_g[l * 64 + lane]), mk = fabsf(P.k_norm_g[l * 64 + lane]);
#pragma unroll
                for (int o_ = 1; o_ < 64; o_ <<= 1) { mq = fmaxf(mq, sx(mq, o_, lane)); mk = fmaxf(mk, sx(mk, o_, lane)); }
                const bool nomax = __builtin_amdgcn_readfirstlane((64.0f * mq * mk * QSCALE < 20.0f) ? 1 : 0) != 0;
                const int r32 = lane & 31, hi = lane >> 5;
                const int ndiff = (l == 0) ? 256 + 32 : 256, ngqa = (l == 0) ? 512 + 64 : 512;
                for (int rep = 0; rep < ATT_REP; ++rep) {
                if (PHASE_ON(2)) for (int un = vcu; un < ndiff; un += G) {
                    int bl, head, qpos0, nt, rowl0;
                    if (un < 256) { bl = un >> 5; head = (un >> 3) & 3; const int qb = un & 7; qpos0 = 256 + qb * 256; nt = NT_LAT; rowl0 = bl * 2048 + qb * 256; }
                    else { const int w = un - 256; bl = w >> 2; head = w & 3; qpos0 = 0; nt = NT_CTX; rowl0 = 16384 + half * 2048 + bl * 256; }
                    f32x16 o[4];
                    const char* Vt = (const char*)(AV + (size_t)(bl * 4 + head) * NT_LAT * 8192);
                    float* scr = SCR + (size_t)bx * 512 * 64 + tid * 4;
                    for (int hf = 0; hf < 2; ++hf) {
                        const int qi_ = (half * 8 + bl) * 8 + head * 2 + hf;
                        const float qmax2 = __uint_as_float(QKMAX[l * 256 + qi_]), kmax2 = __uint_as_float(QKMAX[l * 256 + 128 + qi_]);
                        const bool fixedref = __builtin_amdgcn_readfirstlane((sqrtf(qmax2 * kmax2) < 60.0f) ? 1 : 0) != 0;
                        if (fixedref) attn_pass_simple<4, true>(AQ + ((size_t)(bl * 8 + head * 2 + hf) * LK + qpos0 + wid * 32) * 64, (const char*)(AK + (size_t)(bl * 8 + head * 2 + hf) * NT_LAT * 4096), Vt, nt, lds, o, kmax2);
                        else attn_pass_simple<4, false>(AQ + ((size_t)(bl * 8 + head * 2 + hf) * LK + qpos0 + wid * 32) * 64, (const char*)(AK + (size_t)(bl * 8 + head * 2 + hf) * NT_LAT * 4096), Vt, nt, lds, o, kmax2);
                        if (hf == 0) {
#pragma unroll
                            for (int d0 = 0; d0 < 4; ++d0)
#pragma unroll
                                for (int r4 = 0; r4 < 4; ++r4) *(f32x4*)(scr + (d0 * 4 + r4) * 2048) = (f32x4){o[d0][4 * r4], o[d0][4 * r4 + 1], o[d0][4 * r4 + 2], o[d0][4 * r4 + 3]};
                        }
                    }
                    asm volatile("" : "+v"(scr));
#pragma unroll
                    for (int d0 = 0; d0 < 4; ++d0)
#pragma unroll
                        for (int r4 = 0; r4 < 4; ++r4) { const f32x4 a = *(const f32x4*)(scr + (d0 * 4 + r4) * 2048);
#pragma unroll
                            for (int j = 0; j < 4; ++j) o[d0][4 * r4 + j] = a[j] - lam * o[d0][4 * r4 + j]; }
                    float gsub[4];
#pragma unroll
                    for (int d0 = 0; d0 < 4; ++d0) gsub[d0] = P.subln_g[l * 128 + 32 * d0 + r32] * oml;
                    LAS bf16_t* stg = (LAS bf16_t*)(lds + A_STG + wid * 8192);
#pragma unroll
                    for (int r = 0; r < 16; ++r) {
                        float ss = 0.f;
#pragma unroll
                        for (int d0 = 0; d0 < 4; ++d0) ss += o[d0][r] * o[d0][r];
                        ss += sx(ss, 1, lane); ss += sx(ss, 2, lane); ss += sx(ss, 4, lane); ss += sx(ss, 8, lane); ss += sx(ss, 16, lane);
                        const float rinv = rsqrtf(ss * (1.0f / 128.0f) + EPS);
#pragma unroll
                        for (int d0 = 0; d0 < 4; ++d0) stg[crow(r, hi) * 128 + 32 * d0 + r32] = f2bf(o[d0][r] * rinv * gsub[d0]);
                    }
                    asm volatile("s_waitcnt lgkmcnt(0)" ::: "memory");
                    bf16_t* yb = Y + (size_t)(rowl0 + wid * 32 + (lane >> 4)) * 1536 + head * 128 + (lane & 15) * 8;
                    asm volatile("" : "+v"(yb));
#pragma unroll
                    for (int it = 0; it < 8; ++it) { const u32x4 v = *(const LAS u32x4*)(stg + (it * 4 + (lane >> 4)) * 128 + (lane & 15) * 8); *(u32x4*)(yb + (size_t)it * 4 * 1536) = v; }
                    asm volatile("s_waitcnt lgkmcnt(0)" ::: "memory");
                }
                if (PHASE_ON(3)) for (int un = vcu; un < ngqa; un += G) {
                    int bl, qh, qpos0, nt, rowl0;
                    if (un < 512) { bl = un >> 6; qh = (un >> 3) & 7; const int qb = un & 7; qpos0 = 256 + qb * 256; nt = NT_LAT; rowl0 = bl * 2048 + qb * 256; }
                    else { const int w = un - 512; bl = w >> 3; qh = w & 7; qpos0 = 0; nt = NT_CTX; rowl0 = 16384 + half * 2048 + bl * 256; }
                    f32x16 o[2];
                    const int kvh = qh >> 2;
                    if (nomax) attn_pass<2, true>(BQ + ((size_t)(bl * 8 + qh) * LK + qpos0 + wid * 32) * 64, (const char*)(BK + (size_t)(bl * 2 + kvh) * NT_LAT * 4096), (const char*)(BV + (size_t)(bl * 2 + kvh) * NT_LAT * 4096), nt, lds, o);
                    else attn_pass<2, false>(BQ + ((size_t)(bl * 8 + qh) * LK + qpos0 + wid * 32) * 64, (const char*)(BK + (size_t)(bl * 2 + kvh) * NT_LAT * 4096), (const char*)(BV + (size_t)(bl * 2 + kvh) * NT_LAT * 4096), nt, lds, o);
                    LAS bf16_t* stg = (LAS bf16_t*)(lds + A_STG + wid * 8192);
#pragma unroll
                    for (int r = 0; r < 16; ++r)
#pragma unroll
                        for (int d0 = 0; d0 < 2; ++d0) stg[crow(r, hi) * 64 + 32 * d0 + r32] = f2bf(o[d0][r]);
                    asm volatile("s_waitcnt lgkmcnt(0)" ::: "memory");
                    bf16_t* yb = Y + (size_t)(rowl0 + wid * 32 + (lane >> 3)) * 1536 + 512 + qh * 64 + (lane & 7) * 8;
                    asm volatile("" : "+v"(yb));
#pragma unroll
                    for (int it = 0; it < 4; ++it) { const u32x4 v = *(const LAS u32x4*)(stg + (it * 8 + (lane >> 3)) * 64 + (lane & 7) * 8); *(u32x4*)(yb + (size_t)it * 8 * 1536) = v; }
                    asm volatile("s_waitcnt lgkmcnt(0)" ::: "memory");
                }
                }
            }
            GSYNC();
            {
                pg8::Gemm g{Y, (const bf16_t*)(wt + OFF_WBR), 1536};
                pg8::Order S; S.init(64, (l == 0 && half == 1) ? 16 : 0, 0, 64, D, G, bx);
                EpiMerge E{GT, XN, half};
                if (PHASE_ON(4)) pg8::gemm_phase<EpiMerge>(lds, g, S, E);
                if (l == 0 && half == 1 && bx >= f0) {
                    int tid = threadIdx.x; asm volatile("" : "+v"(tid)); const int lane = tid & 63, wid = __builtin_amdgcn_readfirstlane(tid >> 6);
                    transpose_layer(P, ws, 1, (bx - f0) * 8 + wid, (G - f0) * 8, (LAS float*)(lds + wid * 16384), lane);
                }
            }
            GSYNC();
        }
        {
            pg8::Gemm g{XN, (const bf16_t*)(wt + OFF_WOUT), D};
            pg8::Order S; S.init(128, nctx_tiles, 0, 128, D, G, bx);
            EpiRes E{xlat, P.out, xctx, CTXS, modl + 2 * 1024, XN2, P.norm2_g + l * D, modl + 4 * 1024, RSS + (l == 0 ? 0 : 2 * M_ALL)};
            if (PHASE_ON(5)) pg8::gemm_phase<EpiRes>(lds, g, S, E);
            if (l == 0 && bx >= f0) {
                int tid = threadIdx.x; asm volatile("" : "+v"(tid)); const int lane = tid & 63, wid = __builtin_amdgcn_readfirstlane(tid >> 6);
                sw_sets(ws, MOD, SWIN, SWGU, 1, 3, (bx - f0) * 8 + wid, (G - f0) * 8, lds, tid, lane);
            }
        }
        GSYNC();
        {
            const bool split5 = (l == 0 && G == 256);
            pg8::Gemm g5{XN2, (const bf16_t*)(wt + OFF_WGU), D};
            pg8::Gemm g6{HB, (const bf16_t*)(wt + OFF_WDN), D_FF};
            EpiGlu E5{HB, RSS + (l == 0 ? 0 : 2 * M_ALL), SWGU + (size_t)l * 17 * (2 * D_FF)};
            for (int part = 0; part < (split5 ? 2 : 1); ++part) {
                pg8::Order S;
                if (!split5) S.init(128, nctx_tiles, 0, 128, 2 * D_FF, G, bx);
                else if (part == 0) { S.init(128, 16, 0, 128, 2 * D_FF, G, bx); S.mode = 1; S.nwg = 512; }
                else { S.init(128, 0, 0, 128, 2 * D_FF, G, bx); S.mode = 2; S.offs = 160; }
                if (PHASE_ON(6)) pg8::gemm_phase<EpiGlu>(lds, g5, S, E5);
                if (split5 && part == 1 && bx >= 192) {
                    pg8::Order S6; S6.init(128, 0, 0, 128, D, G, bx); S6.mode = 3; S6.spm = 128 + (bx - 192) % 16; S6.spn = (bx - 192) / 16;
                    EpiRes E6{P.out, P.out, CTXS, CTXS, modl + 5 * 1024, XN, P.norm1_g + D, MOD + (size_t)17 * NMOD + 1024, RSS + M_ALL};
                    pg8::gemm_phase<EpiRes>(lds, g6, S6, E6);
                }
                GSYNC();
            }
            {
                pg8::Order S; S.init(128, split5 ? 0 : nctx_tiles, 0, 128, D, G, bx);
                EpiRes E6{P.out, P.out, CTXS, CTXS, modl + 5 * 1024, (l == 0) ? XN : nullptr, P.norm1_g + D, MOD + (size_t)17 * NMOD + 1024, RSS + M_ALL};
                if (PHASE_ON(7)) pg8::gemm_phase<EpiRes>(lds, g6, S, E6);
            }
        }
        GSYNC();
    }
    int tid = threadIdx.x; asm volatile("" : "+v"(tid)); const int lane = tid & 63, wid = __builtin_amdgcn_readfirstlane(tid >> 6); (void)lane; (void)wid;
    for (int row = vcu * 8 + wid; row < M_LAT; row += G * 8) {
        float* xr = P.out + (size_t)row * D;
        f32x4 v[4]; float s = 0.f;
#pragma unroll
        for (int j = 0; j < 4; ++j) { v[j] = *(const f32x4*)(xr + 4 * lane + 256 * j); s += (v[j][0] * v[j][0] + v[j][1] * v[j][1]) + (v[j][2] * v[j][2] + v[j][3] * v[j][3]); }
        const float rinv = rsqrtf(wave_sum(s, lane) * (1.0f / D) + EPS);
#pragma unroll
        for (int j = 0; j < 4; ++j) *(f32x4*)(xr + 4 * lane + 256 * j) = v[j] * rinv * *(const f32x4*)(P.final_g + 4 * lane + 256 * j);
    }
}

extern "C" void kernel_launch(void* const* d_in, const int* in_sizes, int n_in, void* d_out, int out_size, void* d_ws, size_t ws_size, hipStream_t stream) {
    static int grid = 0;
    if (grid == 0) {
        if (n_in != 24 || out_size != M_LAT * D || ws_size < WS_END) { fprintf(stderr, "kernel_launch: unexpected shapes (n_in %d out %d ws %zu); nothing launched\n", n_in, out_size, ws_size); grid = -1; return; }
        int dev = 0, cus = 0, per_cu = 0;
        if (hipGetDevice(&dev) != hipSuccess || hipDeviceGetAttribute(&cus, hipDeviceAttributeMultiprocessorCount, dev) != hipSuccess) { grid = -1; return; }
        if (hipFuncSetAttribute((const void*)fwd_kernel, hipFuncAttributeMaxDynamicSharedMemorySize, LDS_BYTES) != hipSuccess) { fprintf(stderr, "kernel_launch: hipFuncSetAttribute failed\n"); grid = -1; return; }
        if (hipOccupancyMaxActiveBlocksPerMultiprocessor(&per_cu, (const void*)fwd_kernel, 512, LDS_BYTES) != hipSuccess || per_cu < 1) per_cu = 1;
        (void)hipGetLastError();
        grid = cus < 256 ? cus : 256;
    }
    if (grid < 0) return;
    if (hipMemsetAsync((char*)d_ws + WS_BAR, 0, XCD_BAR_WORDS * 4, stream) != hipSuccess) { fprintf(stderr, "kernel_launch: memset of the barrier words failed\n"); return; }
    Params p{};
    const float** pp = (const float**)&p;
    for (int i = 0; i < 24; ++i) pp[i] = (const float*)d_in[i];
    p.out = (float*)d_out; p.ws = (unsigned char*)d_ws;
    void* args[] = {&p};
    hipError_t e = hipLaunchCooperativeKernel((void*)fwd_kernel, dim3(grid), dim3(512), args, LDS_BYTES, stream);
    if (e != hipSuccess) fprintf(stderr, "cooperative launch failed: %s (grid %d)\n", hipGetErrorString(e), grid);
}
```
